# Optimizing an MI355X kernel written in HIP

```python
import math
import jax, jax.numpy as jnp
from jax import lax
import numpy as np

D_MODEL = 1024
BATCH = 2
SEQ = 8192
DEPTH = 1

HEAD_DIM = 64
HEADS_PER_GROUP = 4
DILATED_GROUPS = ((128, 1), (512, 4), (2048, 16))
N_ATTN_HEADS = HEADS_PER_GROUP * len(DILATED_GROUPS)
ATTN_WIDTH = N_ATTN_HEADS * HEAD_DIM
ATTN_OUT_WIDTH = HEADS_PER_GROUP * HEAD_DIM
ATTN_BLOCK = 128
N_REL_BUCKETS = 32
REL_MAX_DISTANCE = 2048
NEG_INF = -1e30

LRU_WIDTH = D_MODEL
LRU_HEADS = 16
LRU_HEAD_DIM = LRU_WIDTH // LRU_HEADS
CONV_WIDTH = 4
LRU_C = 8.0

N_EXPERT_GROUPS = 4
EXPERTS_PER_GROUP = 8
N_EXPERTS = N_EXPERT_GROUPS * EXPERTS_PER_GROUP
TOP_K = 2
D_EXPERT = 512
MOE_BLOCK = 128

EPS = 1e-6
IN_WIDTH = 3 * ATTN_WIDTH + 2 * LRU_WIDTH + 2 * D_MODEL

kernel_name = "hybrid_dilated_attn_rglru_hmoe_block"


def _rmsnorm(x, g):
    xf = x.astype(jnp.float32)
    y = xf * lax.rsqrt(jnp.mean(xf * xf, axis=-1, keepdims=True) + EPS) * g.astype(jnp.float32)
    return y.astype(x.dtype)


def _t5_causal_bucket(dist):
    max_exact = N_REL_BUCKETS // 2
    d_f = jnp.maximum(dist, max_exact).astype(jnp.float32)
    large = max_exact + (jnp.log(d_f / max_exact) / math.log(REL_MAX_DISTANCE / max_exact)
                         * (N_REL_BUCKETS - max_exact)).astype(jnp.int32)
    large = jnp.minimum(large, N_REL_BUCKETS - 1)
    return jnp.where(dist < max_exact, dist, large)


def _dilated_window_attention(q, k, v, rel_bias, window, dilation):
    B, S, H, Dh = q.shape
    nw = window // dilation
    span = dilation * ATTN_BLOCK
    Sp = -(-S // span) * span
    L = Sp // dilation
    nb = L // ATTN_BLOCK

    def to_blocks(t):
        t = jnp.pad(t, ((0, 0), (0, Sp - S), (0, 0), (0, 0)))
        t = t.reshape(B, L, dilation, H, Dh).transpose(0, 2, 3, 1, 4)
        return t.reshape(B, dilation, H, nb, ATTN_BLOCK, Dh)

    def with_prev(t):
        prev = jnp.pad(t[:, :, :, :-1], ((0, 0), (0, 0), (0, 0), (1, 0), (0, 0), (0, 0)))
        return jnp.concatenate([prev, t], axis=4)

    qb = to_blocks(q)
    kb = with_prev(to_blocks(k))
    vb = with_prev(to_blocks(v))

    qi = jnp.arange(ATTN_BLOCK)[:, None]
    ki = jnp.arange(2 * ATTN_BLOCK)[None, :]
    dist = ATTN_BLOCK + qi - ki
    band = (dist >= 0) & (dist <= nw)
    valid = band[None] & ((jnp.arange(nb)[:, None, None] > 0) | (ki[None] >= ATTN_BLOCK))
    bucket = _t5_causal_bucket(jnp.maximum(dist, 0) * dilation)
    bias = rel_bias.astype(jnp.float32)[bucket].transpose(2, 0, 1)

    s = jnp.einsum('brhnqd,brhnkd->brhnqk', qb, kb) * (HEAD_DIM ** -0.5) + bias[None, None, :, None]
    s = jnp.where(valid[None, None, None], s, NEG_INF)
    m = jnp.max(s, axis=-1, keepdims=True)
    p = jnp.exp(s - m)
    l = jnp.sum(p, axis=-1)
    o = jnp.einsum('brhnqk,brhnkd->brhnqd', p, vb) / l[..., None]
    lse = m[..., 0] + jnp.log(l)

    o = o.reshape(B, dilation, H, L, Dh).transpose(0, 3, 1, 2, 4).reshape(B, Sp, H, Dh)[:, :S]
    lse = lse.reshape(B, dilation, H, L).transpose(0, 3, 1, 2).reshape(B, Sp, H)[:, :S]
    return o, lse


def _dilated_attention_mixer(qkv, rel_bias):
    B, S, _ = qkv.shape
    qkv = qkv.astype(jnp.float32).reshape(B, S, 3, N_ATTN_HEADS, HEAD_DIM)
    q, k, v = qkv[:, :, 0], qkv[:, :, 1], qkv[:, :, 2]
    outs, lses = [], []
    for gi, (window, dilation) in enumerate(DILATED_GROUPS):
        hs = slice(gi * HEADS_PER_GROUP, (gi + 1) * HEADS_PER_GROUP)
        o, lse = _dilated_window_attention(q[:, :, hs], k[:, :, hs], v[:, :, hs], rel_bias[:, hs], window, dilation)
        outs.append(o)
        lses.append(lse)
    o = jnp.stack(outs)
    wts = jax.nn.softmax(jnp.stack(lses), axis=0)
    return jnp.sum(wts[..., None] * o, axis=0).reshape(B, S, ATTN_OUT_WIDTH)


def _rg_lru_mixer(xr, gate_in, conv_w, conv_b, w_rg, b_rg, w_ig, b_ig, lam):
    B, S, W = xr.shape
    xp = jnp.pad(xr, ((0, 0), (CONV_WIDTH - 1, 0), (0, 0)))
    xc = sum(xp[:, j:j + S] * conv_w[j] for j in range(CONV_WIDTH)) + conv_b
    xh = xc.reshape(B, S, LRU_HEADS, LRU_HEAD_DIM)
    r = jax.nn.sigmoid(jnp.einsum('bshi,hij->bshj', xh, w_rg).reshape(B, S, W) + b_rg)
    i = jax.nn.sigmoid(jnp.einsum('bshi,hij->bshj', xh, w_ig).reshape(B, S, W) + b_ig)
    log_a = -LRU_C * r.astype(jnp.float32) * jax.nn.softplus(-lam.astype(jnp.float32))
    a = jnp.exp(log_a)
    b = jnp.sqrt(-jnp.expm1(2.0 * log_a)) * (i * xc).astype(jnp.float32)

    def combine(c1, c2):
        a1, b1 = c1
        a2, b2 = c2
        return a1 * a2, a2 * b1 + b2

    _, h = lax.associative_scan(combine, (a, b), axis=1)
    return h.astype(xr.dtype) * jax.nn.gelu(gate_in)


def _hierarchical_moe(h, w_router_group, w_router_expert, w_gate_up, w_down):
    B, S, D = h.shape
    T = B * S
    ht = h.reshape(T, D)
    hf = ht.astype(jnp.float32)
    p_group = jax.nn.softmax(hf @ w_router_group.astype(jnp.float32), axis=-1)
    g_sel = jnp.argmax(p_group, axis=-1)
    p_sel = jnp.take_along_axis(p_group, g_sel[:, None], axis=1)[:, 0]
    logits_e = (hf @ w_router_expert.astype(jnp.float32)).reshape(T, N_EXPERT_GROUPS, EXPERTS_PER_GROUP)
    logits_sel = jnp.take_along_axis(logits_e, g_sel[:, None, None], axis=1)[:, 0]
    top_vals, top_idx = lax.top_k(logits_sel, TOP_K)
    gate = jax.nn.softmax(top_vals, axis=-1) * p_sel[:, None]
    expert = g_sel[:, None] * EXPERTS_PER_GROUP + top_idx

    TK = T * TOP_K
    e_flat = expert.reshape(TK).astype(jnp.int32)
    tok_flat = jnp.repeat(jnp.arange(T, dtype=jnp.int32), TOP_K)
    w_flat = gate.reshape(TK)
    order = jnp.argsort(e_flat)
    e_s, tok_s, w_s = e_flat[order], tok_flat[order], w_flat[order]
    counts = jnp.bincount(e_flat, length=N_EXPERTS)
    start = jnp.cumsum(counts) - counts
    padded = ((counts + MOE_BLOCK - 1) // MOE_BLOCK) * MOE_BLOCK
    pend = jnp.cumsum(padded)
    pstart = pend - padded
    dest = pstart[e_s] + (jnp.arange(TK, dtype=jnp.int32) - start[e_s])
    P = TK + N_EXPERTS * MOE_BLOCK
    nblk = P // MOE_BLOCK
    buf_tok = jnp.full((P,), T, dtype=jnp.int32).at[dest].set(tok_s)
    buf_w = jnp.zeros((P,), jnp.float32).at[dest].set(w_s)
    block_expert = jnp.minimum(jnp.searchsorted(pend, jnp.arange(nblk) * MOE_BLOCK, side='right'), N_EXPERTS - 1)
    ht_pad = jnp.concatenate([ht, jnp.zeros((1, D), ht.dtype)], axis=0)

    def block_fn(args):
        idx, e = args
        xb = ht_pad[idx]
        gu = xb @ w_gate_up[e]
        g, u = jnp.split(gu, 2, axis=-1)
        return (jax.nn.silu(g) * u) @ w_down[e]

    y_buf = lax.map(block_fn, (buf_tok.reshape(nblk, MOE_BLOCK), block_expert)).reshape(P, D)
    y = jax.ops.segment_sum(y_buf * buf_w[:, None].astype(y_buf.dtype), buf_tok, num_segments=T + 1)[:T]
    return y.reshape(B, S, D).astype(h.dtype)


def setup_inputs(seed: int = 0) -> dict:
    key = jax.random.key(seed)
    ks = jax.random.split(key, 24)
    f32 = jnp.float32
    nrm = lambda k, shape, scale: jax.random.normal(k, shape, f32) * scale
    a0 = jax.random.uniform(ks[10], (DEPTH, LRU_WIDTH), f32, minval=0.9, maxval=0.999)
    s0 = a0 ** (1.0 / LRU_C)
    return {
        "x": nrm(ks[0], (BATCH, SEQ, D_MODEL), 1.0),
        "rel_bias": nrm(ks[1], (N_REL_BUCKETS, N_ATTN_HEADS), 0.5),
        "norm1": 1.0 + nrm(ks[2], (DEPTH, D_MODEL), 0.02),
        "w_in": nrm(ks[3], (DEPTH, D_MODEL, IN_WIDTH), D_MODEL ** -0.5),
        "conv_w": nrm(ks[4], (DEPTH, CONV_WIDTH, LRU_WIDTH), CONV_WIDTH ** -0.5),
        "conv_b": nrm(ks[5], (DEPTH, LRU_WIDTH), 0.02),
        "w_rg": nrm(ks[6], (DEPTH, LRU_HEADS, LRU_HEAD_DIM, LRU_HEAD_DIM), LRU_HEAD_DIM ** -0.5),
        "b_rg": nrm(ks[7], (DEPTH, LRU_WIDTH), 0.1),
        "w_ig": nrm(ks[8], (DEPTH, LRU_HEADS, LRU_HEAD_DIM, LRU_HEAD_DIM), LRU_HEAD_DIM ** -0.5),
        "b_ig": nrm(ks[9], (DEPTH, LRU_WIDTH), 0.1),
        "lru_lambda": jnp.log(s0) - jnp.log1p(-s0),
        "w_proj_attn": nrm(ks[11], (DEPTH, ATTN_OUT_WIDTH, D_MODEL), ATTN_OUT_WIDTH ** -0.5),
        "w_proj_lru": nrm(ks[12], (DEPTH, LRU_WIDTH, D_MODEL), LRU_WIDTH ** -0.5),
        "w_out": nrm(ks[13], (DEPTH, D_MODEL, D_MODEL), D_MODEL ** -0.5),
        "norm2": 1.0 + nrm(ks[14], (DEPTH, D_MODEL), 0.02),
        "w_router_group": nrm(ks[15], (DEPTH, D_MODEL, N_EXPERT_GROUPS), D_MODEL ** -0.5),
        "w_router_expert": nrm(ks[16], (DEPTH, D_MODEL, N_EXPERTS), D_MODEL ** -0.5),
        "w_gate_up": nrm(ks[17], (DEPTH, N_EXPERTS, D_MODEL, 2 * D_EXPERT), D_MODEL ** -0.5),
        "w_down": nrm(ks[18], (DEPTH, N_EXPERTS, D_EXPERT, D_MODEL), D_EXPERT ** -0.5),
        "norm_f": 1.0 + nrm(ks[19], (D_MODEL,), 0.02),
    }


def reference(x, rel_bias, norm1, w_in, conv_w, conv_b, w_rg, b_rg, w_ig, b_ig, lru_lambda,
              w_proj_attn, w_proj_lru, w_out, norm2, w_router_group, w_router_expert,
              w_gate_up, w_down, norm_f):
    for layer in range(DEPTH):
        h = _rmsnorm(x, norm1[layer])
        proj = h @ w_in[layer]
        c1 = 3 * ATTN_WIDTH
        c2 = c1 + LRU_WIDTH
        c3 = c2 + LRU_WIDTH
        qkv, xr, g_lru, g_merge = proj[..., :c1], proj[..., c1:c2], proj[..., c2:c3], proj[..., c3:]
        attn = _dilated_attention_mixer(qkv, rel_bias).astype(x.dtype)
        lru = _rg_lru_mixer(xr, g_lru, conv_w[layer], conv_b[layer], w_rg[layer], b_rg[layer],
                            w_ig[layer], b_ig[layer], lru_lambda[layer])
        gate_a, gate_b = jnp.split(jax.nn.sigmoid(g_merge), 2, axis=-1)
        merged = gate_a * (attn @ w_proj_attn[layer]) + gate_b * (lru @ w_proj_lru[layer])
        x = x + merged @ w_out[layer]
        h2 = _rmsnorm(x, norm2[layer])
        x = x + _hierarchical_moe(h2, w_router_group[layer], w_router_expert[layer],
                                  w_gate_up[layer], w_down[layer])
    return _rmsnorm(x, norm_f)
```

```cpp
#include <hip/hip_runtime.h>
#include <cstdio>
#include <cstdint>

namespace pg8 {
#define PG8_LAS __attribute__((address_space(3)))
typedef unsigned short bf16_t;
typedef short bf16x8 __attribute__((ext_vector_type(8)));
typedef float f32x4 __attribute__((ext_vector_type(4)));
typedef float f32x2 __attribute__((ext_vector_type(2)));
typedef unsigned u32x4 __attribute__((ext_vector_type(4)));
typedef unsigned u32x2 __attribute__((ext_vector_type(2)));
constexpr int BM = 256, BK = 64, HALF = 128, HTB = HALF * BK * 2  , STAGE_BYTES = 8 * HTB, NXCD = 8, WGM = 8;

__host__ __device__ __forceinline__ int lds_byte(int r, int c) { const int st = (r >> 4) * 2 + (c >> 5), rr = r & 15, cc = c & 31, ob = rr * 64 + cc * 2; return st * 1024 + (ob ^ (((ob >> 9) & 1) << 5)); }
__host__ __device__ __forceinline__ void stage_rc(int b, int& R, int& C) { const int st = b / 1024, sb = b % 1024, swz = sb ^ (((sb >> 9) & 1) << 5); R = (st >> 1) * 16 + swz / 64; C = (st & 1) * 32 + (swz % 64) / 2; }
__host__ __device__ __forceinline__ int perm32(int rho) { const int n = rho >> 4, i = rho & 15; return 8 * (i >> 2) + 4 * n + (i & 3); }

struct Unit { int pm, pn, e, r0; };
struct Gemm { const bf16_t* A; const bf16_t* Bt; int M, N, K, pad; };

struct StaticOrder {
    int nM, nN, nwg, G, c, K;
    __host__ __device__ void init(int M, int N, int K_, int G_, int c_) { nM = M / BM; nN = N / BM; nwg = nM * nN; G = G_; c = c_; K = K_; }
    __device__ __forceinline__ bool next(int i, Unit& u) const {
        const long L = (long)i * G + c; if (L >= nwg) return false;
        int wgid = (int)L; { const int q = nwg / NXCD, r = nwg % NXCD, xcd = wgid % NXCD, off = wgid / NXCD; wgid = (xcd < r ? xcd * (q + 1) : r * (q + 1) + (xcd - r) * q) + off; }
        const int nig = WGM * nN, gid = wgid / nig, fm = gid * WGM, gsz = (nM - fm) < WGM ? (nM - fm) : WGM;
        u.pm = fm + ((wgid % nig) % gsz); u.pn = (wgid % nig) / gsz; u.e = 0; u.r0 = 0; return true;
    }
    __device__ __forceinline__ unsigned a_off(const Unit& u, int r) const { return (unsigned)(u.pm * BM + r) * (unsigned)(K * 2); }
    __device__ __forceinline__ size_t b_off(const Unit& u) const { return (size_t)u.pn * BM * K * 2; }
};

__device__ __forceinline__ unsigned cvt_pk_bf16(float lo, float hi) { unsigned r; asm volatile("v_cvt_pk_bf16_f32 %0, %1, %2" : "=v"(r) : "v"(lo), "v"(hi)); return r; }

template <class Epi, class Sched>
__device__ __forceinline__ void gemm_phase(PG8_LAS unsigned char* lds, const Gemm g, const Sched& S, const Epi& E) {
    const int tid = threadIdx.x, wid = __builtin_amdgcn_readfirstlane(tid >> 6), lane = tid & 63, wr = wid >> 2, wc = wid & 3, fr = lane & 15, fq = lane >> 4;
    const int K = g.K, nt = K / BK;
    int sR[2], sC[2]; unsigned voffB[2];
#pragma unroll
    for (int i = 0; i < 2; ++i) { int R, C; stage_rc(tid * 16 + i * 8192, R, C); const int Rb = Epi::PERM ? ((R & ~31) + perm32(R & 31)) : R;
        sR[i] = R; sC[i] = C; voffB[i] = (unsigned)(Rb * K + C) * 2u; }
    const size_t kstep = (size_t)(BK * 2);
    const size_t hstep = (size_t)HALF * K * 2;
    const unsigned ldsw = (unsigned)wid * 1024u;
    const int aoff = lds_byte(wr * 64 + fr, fq * 8), boff = lds_byte(wc * 32 + fr, fq * 8);
#define PG8_SA(b, h) (((b) * 2 + (h)) * HTB)
#define PG8_SB(b, h) ((4 + (b) * 2 + (h)) * HTB)
#define PG8_STAGE(bufoff, gbase, voff) do { _Pragma("unroll") for (int _i = 0; _i < 2; ++_i) \
        __builtin_amdgcn_global_load_lds((const unsigned*)((const char*)(gbase) + (voff)[_i]), (PG8_LAS unsigned*)(lds + (bufoff) + ldsw + _i * 8192), 16, 0, 0); } while (0)
#define PG8_LDA(dst, b, h) do { _Pragma("unroll") for (int m = 0; m < 4; ++m) _Pragma("unroll") for (int k = 0; k < 2; ++k) dst[m][k] = *(const PG8_LAS bf16x8*)(lds + PG8_SA(b, h) + aoff + m * 2048 + k * 1024); } while (0)
#define PG8_LDB(dst, b, h) do { _Pragma("unroll") for (int n = 0; n < 2; ++n) _Pragma("unroll") for (int k = 0; k < 2; ++k) dst[n][k] = *(const PG8_LAS bf16x8*)(lds + PG8_SB(b, h) + boff + n * 2048 + k * 1024); } while (0)
#define PG8_MMA(ai, bj, At, Bt) do { __builtin_amdgcn_s_setprio(1); _Pragma("unroll") for (int m = 0; m < 4; ++m) _Pragma("unroll") for (int n = 0; n < 2; ++n) _Pragma("unroll") for (int k = 0; k < 2; ++k) \
        acc[ai][bj][m][n] = __builtin_amdgcn_mfma_f32_16x16x32_bf16(Bt[n][k], At[m][k], acc[ai][bj][m][n], 0, 0, 0); __builtin_amdgcn_s_setprio(0); } while (0)
#define PG8_WAIT_V(n) asm volatile("s_waitcnt vmcnt(" #n ")" ::: "memory")
#define PG8_WAIT_L(n) asm volatile("s_waitcnt lgkmcnt(" #n ")" ::: "memory")
#define PG8_BAR __builtin_amdgcn_s_barrier()
#define PG8_SCHED __builtin_amdgcn_sched_barrier(0)
    Unit cur, nxt; int ui = 0;
    if (!S.next(0, cur)) return;
    f32x4 acc[2][2][4][2];
#pragma unroll
    for (int a = 0; a < 2; ++a)
#pragma unroll
        for (int b = 0; b < 2; ++b)
#pragma unroll
            for (int m = 0; m < 4; ++m)
#pragma unroll
                for (int n = 0; n < 2; ++n) acc[a][b][m][n] = (f32x4){0.f, 0.f, 0.f, 0.f};
    bf16x8 At[4][2], B0[2][2], B1[2][2];
    unsigned cA0[2], cA1[2], nA0[2], nA1[2];
#pragma unroll
    for (int i = 0; i < 2; ++i) { cA0[i] = S.a_off(cur, sR[i]) + (unsigned)sC[i] * 2u; cA1[i] = S.a_off(cur, HALF + sR[i]) + (unsigned)sC[i] * 2u; }
    const char* gA = (const char*)g.A;
    const char* cB = (const char*)g.Bt + S.b_off(cur);
    PG8_STAGE(PG8_SB(0, 0), cB, voffB); PG8_STAGE(PG8_SA(0, 0), gA, cA0); PG8_STAGE(PG8_SB(0, 1), cB + hstep, voffB); PG8_STAGE(PG8_SA(0, 1), gA, cA1);
    if (wr == 1) PG8_BAR;
    PG8_WAIT_V(4); PG8_BAR;
    PG8_STAGE(PG8_SB(1, 0), cB + kstep, voffB); PG8_STAGE(PG8_SA(1, 0), gA + kstep, cA0); PG8_STAGE(PG8_SB(1, 1), cB + hstep + kstep, voffB);
    PG8_WAIT_V(6); PG8_BAR;
    for (;;) {
        const bool has_next = S.next(ui + 1, nxt);
        const char* nB = has_next ? (const char*)g.Bt + S.b_off(nxt) : cB;
        if (has_next) {
#pragma unroll
            for (int i = 0; i < 2; ++i) { nA0[i] = S.a_off(nxt, sR[i]) + (unsigned)sC[i] * 2u; nA1[i] = S.a_off(nxt, HALF + sR[i]) + (unsigned)sC[i] * 2u; }
        } else {
#pragma unroll
            for (int i = 0; i < 2; ++i) { nA0[i] = cA0[i]; nA1[i] = cA1[i]; }
        }
        for (int t = 0; t < nt; t += 2) {
            const bool last = (t == nt - 2);
            const char* a1 = gA + (size_t)(t + 1) * kstep;
            const char* a2 = last ? gA : gA + (size_t)(t + 2) * kstep; const char* b2 = last ? nB : cB + (size_t)(t + 2) * kstep;
            const char* a3 = a2 + kstep; const char* b3 = b2 + kstep;
            unsigned xA0[2], xA1[2];
#pragma unroll
            for (int i = 0; i < 2; ++i) { xA0[i] = last ? nA0[i] : cA0[i]; xA1[i] = last ? nA1[i] : cA1[i]; }
            PG8_LDB(B0, 0, 0); PG8_SCHED; PG8_LDA(At, 0, 0); PG8_STAGE(PG8_SA(1, 1), a1, cA1);
            PG8_WAIT_L(8); PG8_BAR; PG8_WAIT_L(0); PG8_MMA(0, 0, At, B0); PG8_BAR; PG8_SCHED;
            PG8_LDB(B1, 0, 1); PG8_STAGE(PG8_SB(0, 0), b2, voffB);
            PG8_BAR; PG8_WAIT_L(0); PG8_MMA(0, 1, At, B1); PG8_BAR;
            PG8_LDA(At, 0, 1); PG8_STAGE(PG8_SA(0, 0), a2, xA0);
            PG8_BAR; PG8_WAIT_L(0); PG8_MMA(1, 0, At, B0); PG8_BAR; PG8_SCHED;
            PG8_STAGE(PG8_SB(0, 1), b2 + hstep, voffB);
            PG8_WAIT_V(6); PG8_BAR; PG8_MMA(1, 1, At, B1); PG8_BAR;
            PG8_LDB(B0, 1, 0); PG8_SCHED; PG8_LDA(At, 1, 0); PG8_STAGE(PG8_SA(0, 1), a2, xA1);
            PG8_WAIT_L(8); PG8_BAR; PG8_WAIT_L(0); PG8_MMA(0, 0, At, B0); PG8_BAR; PG8_SCHED;
            PG8_LDB(B1, 1, 1); PG8_STAGE(PG8_SB(1, 0), b3, voffB);
            PG8_BAR; PG8_WAIT_L(0); PG8_MMA(0, 1, At, B1); PG8_BAR;
            PG8_LDA(At, 1, 1); PG8_STAGE(PG8_SA(1, 0), a3, xA0);
            PG8_BAR; PG8_WAIT_L(0); PG8_MMA(1, 0, At, B0); PG8_BAR; PG8_SCHED;
            PG8_STAGE(PG8_SB(1, 1), b3 + hstep, voffB);
            PG8_WAIT_V(6); PG8_BAR; PG8_MMA(1, 1, At, B1); PG8_BAR;
        }
        E(acc, cur, wr, wc, fr, fq);
        if (!has_next) break;
#pragma unroll
        for (int a = 0; a < 2; ++a)
#pragma unroll
            for (int b = 0; b < 2; ++b)
#pragma unroll
                for (int m = 0; m < 4; ++m)
#pragma unroll
                    for (int n = 0; n < 2; ++n) acc[a][b][m][n] = (f32x4){0.f, 0.f, 0.f, 0.f};
        cur = nxt; cB = nB; ++ui;
#pragma unroll
        for (int i = 0; i < 2; ++i) { cA0[i] = nA0[i]; cA1[i] = nA1[i]; }
    }
    PG8_WAIT_V(0);
    if (wr == 0) PG8_BAR;
    PG8_BAR;
#undef PG8_SA
#undef PG8_SB
#undef PG8_STAGE
#undef PG8_LDA
#undef PG8_LDB
#undef PG8_MMA
#undef PG8_WAIT_V
#undef PG8_WAIT_L
#undef PG8_BAR
#undef PG8_SCHED
}
}

#define GAS __attribute__((address_space(1)))
#define LAS __attribute__((address_space(3)))
typedef unsigned short bf16;
typedef pg8::f32x4 f32x4;
typedef pg8::f32x2 f32x2;
typedef pg8::u32x4 u32x4;
typedef pg8::u32x2 u32x2;
typedef pg8::bf16x8 bf16x8;
using pg8::cvt_pk_bf16;

constexpr int SEQ = 8192, DM = 1024, M = 2 * SEQ;
constexpr int INW = 6400, C_K = 768, C_V = 1536, C_XR = 2304, C_GL = 3328, C_GM = 4352;
constexpr int NEXP = 32, DEXP = 512, CAP = 16384, MAXTILES = 160;
constexpr float EPS = 1e-6f;
constexpr int NWAVES = 8;
constexpr int LDS_BYTES = 147456;
constexpr int TAB_OFF = 131072 + 1024;

constexpr size_t MiB = 1u << 20;
constexpr size_t WS_CTL = 0, CTL_ZERO_BYTES = 1 * MiB;
constexpr size_t WS_WIN = 2 * MiB;
constexpr size_t WS_WPA = 15 * MiB;
constexpr size_t WS_WPL = 16 * MiB;
constexpr size_t WS_WOUT = 18 * MiB;
constexpr size_t WS_WGU = 20 * MiB;
constexpr size_t WS_WD = 84 * MiB;
constexpr size_t WS_H = 116 * MiB;
constexpr size_t WS_PROJ = 148 * MiB;
constexpr size_t WS_ACT = WS_PROJ, WS_Y = WS_PROJ + 40 * MiB;
constexpr size_t WS_HL = 348 * MiB;
constexpr size_t WS_MERGED = WS_HL;
constexpr size_t WS_PC = 380 * MiB;
constexpr size_t WS_PAG = WS_PC;
constexpr size_t WS_AGG = 412 * MiB;
constexpr size_t WS_LRUO = 413 * MiB;
constexpr size_t WS_ATT = WS_H;
constexpr size_t WS_ROUTE = 509 * MiB;
constexpr size_t WS_TOK = 510 * MiB;
constexpr size_t WS_AF = 445 * MiB;
constexpr size_t WS_END = 512 * MiB;
constexpr int CW_CNT = 64;

__device__ __forceinline__ float bf2f(unsigned short b) { return __uint_as_float(((unsigned)b) << 16); }
__device__ __forceinline__ float bflo(unsigned w) { return __uint_as_float(w << 16); }
__device__ __forceinline__ float bfhi(unsigned w) { return __uint_as_float(w & 0xffff0000u); }
__device__ __forceinline__ unsigned short f2bf(float f) { return (unsigned short)(cvt_pk_bf16(f, 0.f) & 0xffffu); }
__device__ __forceinline__ float wave_sum(float v) {
#pragma unroll
    for (int o = 1; o < 64; o <<= 1) v += __shfl_xor(v, o);
    return v;
}
__device__ __forceinline__ float wave_max(float v) {
#pragma unroll
    for (int o = 1; o < 64; o <<= 1) v = fmaxf(v, __shfl_xor(v, o));
    return v;
}
__device__ __forceinline__ float sigmoid_f(float x) { return __builtin_amdgcn_rcpf(1.0f + __builtin_amdgcn_exp2f(-1.4426950408889634f * x)); }
__device__ __forceinline__ float gelu_tanh_f(float x) { const float u = 0.7978845608028654f * (x + 0.044715f * x * x * x); return x * sigmoid_f(2.0f * u); }

__device__ const unsigned char BUCKET[3][132] = {
 {0,1,2,3,4,5,6,7,8,9,10,11,12,13,14,15,16,16,16,16,16,16,17,17,17,17,17,17,17,17,18,18,18,18,18,18,18,18,18,18,19,19,19,19,19,19,19,19,19,19,19,19,19,19,20,20,20,20,20,20,20,20,20,20,20,20,20,20,20,20,20,20,20,21,21,21,21,21,21,21,21,21,21,21,21,21,21,21,21,21,21,21,21,21,21,21,21,21,21,22,22,22,22,22,22,22,22,22,22,22,22,22,22,22,22,22,22,22,22,22,22,22,22,22,22,22,22,22,22,0,0,0},
 {0,4,8,12,16,16,17,17,18,18,19,19,19,19,20,20,20,20,20,21,21,21,21,21,21,22,22,22,22,22,22,22,22,22,23,23,23,23,23,23,23,23,23,23,23,23,24,24,24,24,24,24,24,24,24,24,24,24,24,24,24,24,25,25,25,25,25,25,25,25,25,25,25,25,25,25,25,25,25,25,25,25,25,26,26,26,26,26,26,26,26,26,26,26,26,26,26,26,26,26,26,26,26,26,26,26,26,26,26,26,26,26,26,27,27,27,27,27,27,27,27,27,27,27,27,27,27,27,27,0,0,0},
 {0,16,18,19,20,21,21,22,22,23,23,23,24,24,24,24,25,25,25,25,25,26,26,26,26,26,26,26,26,27,27,27,27,27,27,27,27,27,27,28,28,28,28,28,28,28,28,28,28,28,28,28,29,29,29,29,29,29,29,29,29,29,29,29,29,29,29,29,29,29,30,30,30,30,30,30,30,30,30,30,30,30,30,30,30,30,30,30,30,30,30,30,30,30,30,31,31,31,31,31,31,31,31,31,31,31,31,31,31,31,31,31,31,31,31,31,31,31,31,31,31,31,31,31,31,31,31,31,31,0,0,0}};

struct EpiProj {
    static constexpr bool PERM = true;
    bf16* O;
    __device__ __forceinline__ void operator()(const f32x4 (&acc)[2][2][4][2], const pg8::Unit& u, int wr, int wc, int fr, int fq) const {
        const int row0 = u.pm * 256 + wr * 64 + fr, col0 = u.pn * 256 + wc * 32 + 8 * fq;
        const int mode = u.pn < 3 ? 0 : (u.pn < 13 ? 1 : (u.pn < 17 ? 2 : 3));
#pragma unroll
        for (int ai = 0; ai < 2; ++ai)
#pragma unroll
            for (int m = 0; m < 4; ++m) { bf16* rowp = O + (size_t)(row0 + ai * 128 + m * 16) * INW + col0;
#pragma unroll
                for (int bj = 0; bj < 2; ++bj) { f32x4 v0 = acc[ai][bj][m][0], v1 = acc[ai][bj][m][1];
                    if (mode == 0) { v0 = v0 * 0.125f; v1 = v1 * 0.125f; }
                    else if (mode == 2) {
#pragma unroll
                        for (int j = 0; j < 4; ++j) { v0[j] = gelu_tanh_f(v0[j]); v1[j] = gelu_tanh_f(v1[j]); } }
                    else if (mode == 3) {
#pragma unroll
                        for (int j = 0; j < 4; ++j) { v0[j] = sigmoid_f(v0[j]); v1[j] = sigmoid_f(v1[j]); } }
                    u32x4 w; w.x = cvt_pk_bf16(v0[0], v0[1]); w.y = cvt_pk_bf16(v0[2], v0[3]); w.z = cvt_pk_bf16(v1[0], v1[1]); w.w = cvt_pk_bf16(v1[2], v1[3]);
                    *(u32x4*)(rowp + bj * 128) = w; } }
    }
};
template <bool HAS_ADD> struct EpiGate {
    static constexpr bool PERM = true;
    bf16* O; const bf16* PROJ; const bf16* ADD; int gcol0, pad;
    __device__ __forceinline__ void operator()(const f32x4 (&acc)[2][2][4][2], const pg8::Unit& u, int wr, int wc, int fr, int fq) const {
        const int row0 = u.pm * 256 + wr * 64 + fr, col0 = u.pn * 256 + wc * 32 + 8 * fq;
#pragma unroll
        for (int ai = 0; ai < 2; ++ai)
#pragma unroll
            for (int m = 0; m < 4; ++m) { const size_t r = (size_t)(row0 + ai * 128 + m * 16);
#pragma unroll
                for (int bj = 0; bj < 2; ++bj) { const int c = col0 + bj * 128;
                    const u32x4 gv = *(const u32x4*)(PROJ + r * INW + gcol0 + c);
                    f32x4 v0 = acc[ai][bj][m][0], v1 = acc[ai][bj][m][1];
                    v0[0] *= bflo(gv.x); v0[1] *= bfhi(gv.x); v0[2] *= bflo(gv.y); v0[3] *= bfhi(gv.y);
                    v1[0] *= bflo(gv.z); v1[1] *= bfhi(gv.z); v1[2] *= bflo(gv.w); v1[3] *= bfhi(gv.w);
                    if (HAS_ADD) { const u32x4 av = *(const u32x4*)(ADD + r * DM + c);
                        v0[0] += bflo(av.x); v0[1] += bfhi(av.x); v0[2] += bflo(av.y); v0[3] += bfhi(av.y);
                        v1[0] += bflo(av.z); v1[1] += bfhi(av.z); v1[2] += bflo(av.w); v1[3] += bfhi(av.w); }
                    u32x4 w; w.x = cvt_pk_bf16(v0[0], v0[1]); w.y = cvt_pk_bf16(v0[2], v0[3]); w.z = cvt_pk_bf16(v1[0], v1[1]); w.w = cvt_pk_bf16(v1[2], v1[3]);
                    *(u32x4*)(O + r * DM + c) = w; } }
    }
};
struct EpiResid {
    static constexpr bool PERM = false;
    float* C; const float* X;
    __device__ __forceinline__ void operator()(const f32x4 (&acc)[2][2][4][2], const pg8::Unit& u, int wr, int wc, int fr, int fq) const {
        const int row0 = u.pm * 256 + wr * 64 + fr, col0 = u.pn * 256 + wc * 32 + 4 * fq;
#pragma unroll
        for (int ai = 0; ai < 2; ++ai)
#pragma unroll
            for (int m = 0; m < 4; ++m) { const size_t off = (size_t)(row0 + ai * 128 + m * 16) * DM + col0;
#pragma unroll
                for (int bj = 0; bj < 2; ++bj)
#pragma unroll
                    for (int n = 0; n < 2; ++n) { const f32x4 xv = *(const f32x4*)(X + off + bj * 128 + n * 16); *(f32x4*)(C + off + bj * 128 + n * 16) = acc[ai][bj][m][n] + xv; } }
    }
};
struct EpiSwiglu {
    static constexpr bool PERM = true;
    bf16* O;
    __device__ __forceinline__ void operator()(const f32x4 (&acc)[2][2][4][2], const pg8::Unit& u, int wr, int wc, int fr, int fq) const {
        const int row0 = u.pm * 256 + wr * 64 + fr, col0 = u.pn * 128 + wc * 32 + 8 * fq;
#pragma unroll
        for (int ai = 0; ai < 2; ++ai)
#pragma unroll
            for (int m = 0; m < 4; ++m) { bf16* rowp = O + (size_t)(row0 + ai * 128 + m * 16) * DEXP + col0;
                f32x4 v0, v1;
#pragma unroll
                for (int j = 0; j < 4; ++j) { const float g0 = acc[ai][0][m][0][j], g1 = acc[ai][0][m][1][j];
                    v0[j] = g0 * sigmoid_f(g0) * acc[ai][1][m][0][j]; v1[j] = g1 * sigmoid_f(g1) * acc[ai][1][m][1][j]; }
                u32x4 w; w.x = cvt_pk_bf16(v0[0], v0[1]); w.y = cvt_pk_bf16(v0[2], v0[3]); w.z = cvt_pk_bf16(v1[0], v1[1]); w.w = cvt_pk_bf16(v1[2], v1[3]);
                *(u32x4*)rowp = w; }
    }
};
struct EpiPlain {
    static constexpr bool PERM = true;
    bf16* O; int ldc, pad;
    __device__ __forceinline__ void operator()(const f32x4 (&acc)[2][2][4][2], const pg8::Unit& u, int wr, int wc, int fr, int fq) const {
        const int row0 = u.pm * 256 + wr * 64 + fr, col0 = u.pn * 256 + wc * 32 + 8 * fq;
#pragma unroll
        for (int ai = 0; ai < 2; ++ai)
#pragma unroll
            for (int m = 0; m < 4; ++m) { bf16* rowp = O + (size_t)(row0 + ai * 128 + m * 16) * ldc + col0;
#pragma unroll
                for (int bj = 0; bj < 2; ++bj) { const f32x4 v0 = acc[ai][bj][m][0], v1 = acc[ai][bj][m][1];
                    u32x4 w; w.x = cvt_pk_bf16(v0[0], v0[1]); w.y = cvt_pk_bf16(v0[2], v0[3]); w.z = cvt_pk_bf16(v1[0], v1[1]); w.w = cvt_pk_bf16(v1[2], v1[3]);
                    *(u32x4*)(rowp + bj * 128) = w; } }
    }
};

struct MoeOrder {
    const LAS int* tab; const int* tok; const unsigned* cnt; int G, c, K, gather; size_t bstride;
    __device__ __forceinline__ bool next(int i, pg8::Unit& u) const {
        const int L = i * G + c; const int nt = tab[0]; if (L >= nt * 4) return false;
        const int t = L >> 2, info = tab[1 + t]; u.pm = t; u.pn = L & 3; u.e = info & 255; u.r0 = info >> 8; return true;
    }
    __device__ __forceinline__ unsigned a_off(const pg8::Unit& u, int r) const {
        if (gather) { const int n = (int)cnt[u.e]; int idx = u.r0 + r; idx = idx < n ? idx : n - 1; const int t = tok[u.e * CAP + idx]; return (unsigned)t * (unsigned)(K * 2); }
        return (unsigned)(u.pm * 256 + r) * (unsigned)(K * 2);
    }
    __device__ __forceinline__ size_t b_off(const pg8::Unit& u) const { return (size_t)u.e * bstride + (size_t)u.pn * 256 * K * 2; }
};
__device__ __forceinline__ void build_moe_table(LAS int* tab, const unsigned* cnt) {
    int nt = 0;
    for (int e = 0; e < NEXP; ++e) { const int n = (int)cnt[e]; for (int r0 = 0; r0 < n; r0 += 256) { tab[1 + nt] = e | (r0 << 8); ++nt; } }
    tab[0] = nt;
}

struct P { const float* in[20]; float* out; unsigned char* ws; };

__device__ __forceinline__ void transpose_item(const float* W, int ldw, bf16* WT, int K, int drow0, int k0, int n0, LAS float* scr, int lane) {
#pragma unroll 8
    for (int i = 0; i < 32; ++i) { const int kk = 2 * i + (lane >> 5); scr[kk * 33 + (lane & 31)] = W[(size_t)(k0 + kk) * ldw + n0 + (lane & 31)]; }
    asm volatile("s_waitcnt lgkmcnt(0)" ::: "memory");
    const int c = lane & 7;
#pragma unroll
    for (int j = 0; j < 4; ++j) { const int n = (lane >> 3) + 8 * j; const LAS float* s = scr + (8 * c) * 33 + n;
        u32x4 o; o.x = cvt_pk_bf16(s[0 * 33], s[1 * 33]); o.y = cvt_pk_bf16(s[2 * 33], s[3 * 33]); o.z = cvt_pk_bf16(s[4 * 33], s[5 * 33]); o.w = cvt_pk_bf16(s[6 * 33], s[7 * 33]);
        *(u32x4*)(WT + (size_t)(drow0 + n) * K + k0 + 8 * c) = o; }
    asm volatile("s_waitcnt lgkmcnt(0)" ::: "memory");
}
__device__ __forceinline__ void rms_row_to_bf16(const float* xrow, const float* gain, bf16* orow, int lane) {
    const f32x4* xr = (const f32x4*)xrow + lane; const f32x4* gr = (const f32x4*)gain + lane;
    f32x4 v[4]; float s = 0.f;
#pragma unroll
    for (int j = 0; j < 4; ++j) { v[j] = xr[64 * j]; s += (v[j].x * v[j].x + v[j].y * v[j].y) + (v[j].z * v[j].z + v[j].w * v[j].w); }
    const float rinv = 1.0f / sqrtf(wave_sum(s) * (1.f / DM) + EPS);
    u32x2* o8 = (u32x2*)orow + lane;
#pragma unroll
    for (int j = 0; j < 4; ++j) { const f32x4 g = gr[64 * j]; u32x2 w; w.x = cvt_pk_bf16(v[j].x * rinv * g.x, v[j].y * rinv * g.y); w.y = cvt_pk_bf16(v[j].z * rinv * g.z, v[j].w * rinv * g.w); o8[64 * j] = w; }
}
__global__ void __launch_bounds__(512, 2) k_prologue(P p) {
    extern __shared__ __attribute__((aligned(16))) unsigned char lds[];
    const int tid = threadIdx.x, lane = tid & 63, wave = tid >> 6;
    LAS float* scr = (LAS float*)((LAS unsigned char*)lds + wave * 16384);
    const int gw = blockIdx.x * NWAVES + wave, NGW = gridDim.x * NWAVES;
    unsigned char* ws = p.ws;
    constexpr int I_IN = 16 * 200, I_PA = 4 * 32, I_PL = 16 * 32, I_OUT = 16 * 32, I_GU = 32 * 16 * 32, I_D = 32 * 8 * 32;
    constexpr int NITEMS = I_IN + I_PA + I_PL + I_OUT + I_GU + I_D;
    for (int it = gw; it < NITEMS; it += NGW) {
        int r = it;
        if (r < I_IN) { const int kb = r / 200, nb = r % 200; transpose_item(p.in[3], INW, (bf16*)(ws + WS_WIN), 1024, 32 * nb, 64 * kb, 32 * nb, scr, lane); continue; } r -= I_IN;
        if (r < I_PA) { const int kb = r / 32, nb = r % 32; transpose_item(p.in[11], 1024, (bf16*)(ws + WS_WPA), 256, 32 * nb, 64 * kb, 32 * nb, scr, lane); continue; } r -= I_PA;
        if (r < I_PL) { const int kb = r / 32, nb = r % 32; transpose_item(p.in[12], 1024, (bf16*)(ws + WS_WPL), 1024, 32 * nb, 64 * kb, 32 * nb, scr, lane); continue; } r -= I_PL;
        if (r < I_OUT) { const int kb = r / 32, nb = r % 32; transpose_item(p.in[13], 1024, (bf16*)(ws + WS_WOUT), 1024, 32 * nb, 64 * kb, 32 * nb, scr, lane); continue; } r -= I_OUT;
        if (r < I_GU) { const int e = r / 512, q = r % 512, kb = q / 32, nb = q % 32, n0 = 32 * nb, j = n0 & 511, isu = n0 >> 9;
            transpose_item(p.in[17] + (size_t)e * 1024 * 1024, 1024, (bf16*)(ws + WS_WGU) + (size_t)e * 1024 * 1024, 1024, 256 * (j >> 7) + 128 * isu + (j & 127), 64 * kb, n0, scr, lane); continue; } r -= I_GU;
        { const int e = r / 256, q = r % 256, kb = q / 32, nb = q % 32;
            transpose_item(p.in[18] + (size_t)e * 512 * 1024, 1024, (bf16*)(ws + WS_WD) + (size_t)e * 1024 * 512, 512, 32 * nb, 64 * kb, 32 * nb, scr, lane); }
    }
    for (int m = gw; m < M; m += NGW) rms_row_to_bf16(p.in[0] + (size_t)m * DM, p.in[2], (bf16*)(ws + WS_H) + (size_t)m * DM, lane);
}

template <class Epi> __global__ void __launch_bounds__(512, 2) k_gemm(pg8::Gemm g, Epi E) {
    extern __shared__ __attribute__((aligned(16))) unsigned char lds[];
    pg8::StaticOrder S; S.init(g.M, g.N, g.K, (int)gridDim.x, (int)blockIdx.x);
    pg8::gemm_phase<Epi, pg8::StaticOrder>((LAS unsigned char*)lds, g, S, E);
}
struct MoeArgs { const unsigned* cnt; const int* tok; size_t bstride; int gather, pad; };
template <class Epi> __global__ void __launch_bounds__(512, 2) k_gemm_moe(pg8::Gemm g, Epi E, MoeArgs ma) {
    const unsigned* cnt = ma.cnt; const int* tok = ma.tok; const int gather = ma.gather; const size_t bstride = ma.bstride;
    extern __shared__ __attribute__((aligned(16))) unsigned char lds[];
    LAS int* tab = (LAS int*)((LAS unsigned char*)lds + TAB_OFF);
    if (threadIdx.x == 0) build_moe_table(tab, cnt);
    __syncthreads();
    MoeOrder S; S.tab = tab; S.tok = tok; S.cnt = cnt; S.G = (int)gridDim.x; S.c = (int)blockIdx.x; S.K = g.K; S.gather = gather; S.bstride = bstride;
    pg8::gemm_phase<Epi, MoeOrder>((LAS unsigned char*)lds, g, S, E);
}

__global__ void __launch_bounds__(256) k_attn_simple(const bf16* __restrict__ PROJ, const float* __restrict__ rel_bias, bf16* __restrict__ ATT) {
    const int lane = threadIdx.x & 63; const int gw = (blockIdx.x * blockDim.x + threadIdx.x) >> 6, NGW = (gridDim.x * blockDim.x) >> 6;
    for (int task = gw; task < M * 4; task += NGW) {
        const int row = task >> 2, hh = task & 3, t = row & (SEQ - 1);
        float og[3], lg[3];
#pragma unroll
        for (int g = 0; g < 3; ++g) {
            const int d = g == 0 ? 1 : (g == 1 ? 4 : 16), h = 4 * g + hh;
            const u32x4* qp = (const u32x4*)(PROJ + (size_t)row * INW + h * 64);
            u32x4 q[8];
#pragma unroll
            for (int i = 0; i < 8; ++i) q[i] = qp[i];
            float s[3];
#pragma unroll
            for (int sl = 0; sl < 3; ++sl) { const int j = lane + 64 * sl; const bool valid = (j <= 128) && (t - j * d >= 0);
                float dot = -1e30f;
                if (valid) { const u32x4* kp = (const u32x4*)(PROJ + (size_t)(row - j * d) * INW + C_K + h * 64); dot = 0.f;
#pragma unroll
                    for (int i = 0; i < 8; ++i) { const u32x4 kv = kp[i];
                        dot += bflo(q[i].x) * bflo(kv.x) + bfhi(q[i].x) * bfhi(kv.x) + bflo(q[i].y) * bflo(kv.y) + bfhi(q[i].y) * bfhi(kv.y)
                             + bflo(q[i].z) * bflo(kv.z) + bfhi(q[i].z) * bfhi(kv.z) + bflo(q[i].w) * bflo(kv.w) + bfhi(q[i].w) * bfhi(kv.w); }
                    dot += rel_bias[(int)BUCKET[g][j] * 12 + h]; }
                s[sl] = dot; }
            const float mx = wave_max(fmaxf(fmaxf(s[0], s[1]), s[2]));
            float pr[3]; float ls = 0.f;
#pragma unroll
            for (int sl = 0; sl < 3; ++sl) { pr[sl] = s[sl] > -1e29f ? __expf(s[sl] - mx) : 0.f; ls += pr[sl]; }
            const float l = wave_sum(ls);
            float o = 0.f;
            for (int j = 0; j <= 128; ++j) { if (t - j * d < 0) break;
                const float pj = __shfl(j < 64 ? pr[0] : (j < 128 ? pr[1] : pr[2]), j & 63);
                o += pj * bf2f(PROJ[(size_t)(row - j * d) * INW + C_V + h * 64 + lane]); }
            og[g] = o / l; lg[g] = mx + __logf(l);
        }
        const float ml = fmaxf(fmaxf(lg[0], lg[1]), lg[2]);
        const float w0 = __expf(lg[0] - ml), w1 = __expf(lg[1] - ml), w2 = __expf(lg[2] - ml);
        ATT[(size_t)row * 256 + hh * 64 + lane] = f2bf((w0 * og[0] + w1 * og[1] + w2 * og[2]) / (w0 + w1 + w2));
    }
}

__global__ void __launch_bounds__(256) k_lru_gates_simple(const bf16* __restrict__ PROJ, P p, float* __restrict__ AF, float* __restrict__ BF) {
    const float* conv_w = p.in[4]; const float* conv_b = p.in[5]; const float* w_rg = p.in[6]; const float* b_rg = p.in[7]; const float* w_ig = p.in[8]; const float* b_ig = p.in[9]; const float* lam = p.in[10];
    const int lane = threadIdx.x & 63; const int gw = (blockIdx.x * blockDim.x + threadIdx.x) >> 6, NGW = (gridDim.x * blockDim.x) >> 6;
    for (int task = gw; task < M * 16; task += NGW) {
        const int row = task >> 4, h = task & 15, t = row & (SEQ - 1), c = h * 64 + lane;
        float xc = conv_b[c];
#pragma unroll
        for (int j = 0; j < 4; ++j) { const int tt = t - 3 + j; if (tt >= 0) xc += conv_w[j * 1024 + c] * bf2f(PROJ[(size_t)(row - 3 + j) * INW + C_XR + c]); }
        float rp = b_rg[c], ip = b_ig[c];
        for (int i = 0; i < 64; ++i) { const float xi = __shfl(xc, i); rp += xi * w_rg[(h * 64 + i) * 64 + lane]; ip += xi * w_ig[(h * 64 + i) * 64 + lane]; }
        const float r = 1.f / (1.f + expf(-rp)), ig = 1.f / (1.f + expf(-ip));
        const float nl = -lam[c]; const float sp = nl > 20.f ? nl : log1pf(expf(nl));
        const float log_a = -8.0f * r * sp; const float a = expf(log_a);
        const float b = sqrtf(-expm1f(2.0f * log_a)) * (ig * xc);
        AF[(size_t)row * DM + c] = a; BF[(size_t)row * DM + c] = b;
    }
}
__global__ void __launch_bounds__(256) k_lru_scan_local(const float* __restrict__ AF, const float* __restrict__ BF, bf16* __restrict__ HL, bf16* __restrict__ PC, float* __restrict__ AGG) {
    const int gt = blockIdx.x * blockDim.x + threadIdx.x; if (gt >= 2 * 64 * 1024) return;
    const int ch = gt & 1023, ck = (gt >> 10) & 63, b = gt >> 16; const size_t row0 = (size_t)b * SEQ + ck * 128;
    float h = 0.f, pc = 1.f;
    for (int i = 0; i < 128; ++i) { const float a = AF[(row0 + i) * DM + ch], bb = BF[(row0 + i) * DM + ch]; pc *= a; h = a * h + bb; HL[(row0 + i) * DM + ch] = f2bf(h); PC[(row0 + i) * DM + ch] = f2bf(pc); }
    AGG[((size_t)(b * 64 + ck) * 2 + 0) * 1024 + ch] = pc; AGG[((size_t)(b * 64 + ck) * 2 + 1) * 1024 + ch] = h;
}
__global__ void __launch_bounds__(256) k_lru_fixup(const bf16* __restrict__ HL, const bf16* __restrict__ PC, const float* __restrict__ AGG, const bf16* __restrict__ PROJ, bf16* __restrict__ LRUO) {
    const int gt = blockIdx.x * blockDim.x + threadIdx.x; if (gt >= 2 * 64 * 1024) return;
    const int ch = gt & 1023, ck = (gt >> 10) & 63, b = gt >> 16; const size_t row0 = (size_t)b * SEQ + ck * 128;
    float carry = 0.f;
    for (int k = 0; k < ck; ++k) carry = AGG[((size_t)(b * 64 + k) * 2 + 0) * 1024 + ch] * carry + AGG[((size_t)(b * 64 + k) * 2 + 1) * 1024 + ch];
    for (int i = 0; i < 128; ++i) { const float h = bf2f(HL[(row0 + i) * DM + ch]) + bf2f(PC[(row0 + i) * DM + ch]) * carry; LRUO[(row0 + i) * DM + ch] = f2bf(h * bf2f(PROJ[(row0 + i) * INW + C_GL + ch])); }
}

__global__ void __launch_bounds__(256) k_router_simple(const float* __restrict__ X1, P p, bf16* __restrict__ H2, int* __restrict__ ROUTE, int* __restrict__ TOK, unsigned* __restrict__ cnt) {
    const float* g2 = p.in[14]; const float* wg = p.in[15]; const float* we = p.in[16];
    const int lane = threadIdx.x & 63; const int gw = (blockIdx.x * blockDim.x + threadIdx.x) >> 6, NGW = (gridDim.x * blockDim.x) >> 6;
    for (int row = gw; row < M; row += NGW) {
        const f32x4* xr = (const f32x4*)(X1 + (size_t)row * DM) + lane; const f32x4* gr = (const f32x4*)g2 + lane;
        f32x4 v[4]; float s = 0.f;
#pragma unroll
        for (int j = 0; j < 4; ++j) { v[j] = xr[64 * j]; s += (v[j].x * v[j].x + v[j].y * v[j].y) + (v[j].z * v[j].z + v[j].w * v[j].w); }
        const float rinv = 1.0f / sqrtf(wave_sum(s) * (1.f / DM) + EPS);
        u32x2* o8 = (u32x2*)(H2 + (size_t)row * DM) + lane;
#pragma unroll
        for (int j = 0; j < 4; ++j) { const f32x4 g = gr[64 * j]; v[j].x = v[j].x * rinv * g.x; v[j].y = v[j].y * rinv * g.y; v[j].z = v[j].z * rinv * g.z; v[j].w = v[j].w * rinv * g.w;
            u32x2 w; w.x = cvt_pk_bf16(v[j].x, v[j].y); w.y = cvt_pk_bf16(v[j].z, v[j].w); o8[64 * j] = w; }
        float lgt[4], le[32];
#pragma unroll
        for (int c = 0; c < 4; ++c) lgt[c] = 0.f;
#pragma unroll
        for (int c = 0; c < 32; ++c) le[c] = 0.f;
#pragma unroll
        for (int j = 0; j < 4; ++j)
#pragma unroll
            for (int i = 0; i < 4; ++i) { const int k = 256 * j + 4 * lane + i; const float hv = v[j][i];
                const f32x4 wgv = *(const f32x4*)(wg + (size_t)k * 4);
                lgt[0] += hv * wgv.x; lgt[1] += hv * wgv.y; lgt[2] += hv * wgv.z; lgt[3] += hv * wgv.w;
#pragma unroll
                for (int c4 = 0; c4 < 8; ++c4) { const f32x4 w4 = *(const f32x4*)(we + (size_t)k * 32 + c4 * 4); le[c4 * 4 + 0] += hv * w4.x; le[c4 * 4 + 1] += hv * w4.y; le[c4 * 4 + 2] += hv * w4.z; le[c4 * 4 + 3] += hv * w4.w; } }
#pragma unroll
        for (int c = 0; c < 4; ++c) lgt[c] = wave_sum(lgt[c]);
#pragma unroll
        for (int c = 0; c < 32; ++c) le[c] = wave_sum(le[c]);
        int gs = 0; float gm = lgt[0];
#pragma unroll
        for (int c = 1; c < 4; ++c) if (lgt[c] > gm) { gm = lgt[c]; gs = c; }
        float den = 0.f;
#pragma unroll
        for (int c = 0; c < 4; ++c) den += expf(lgt[c] - gm);
        const float psel = 1.0f / den;
        float ls[8];
#pragma unroll
        for (int c = 0; c < 8; ++c) ls[c] = gs == 0 ? le[c] : (gs == 1 ? le[8 + c] : (gs == 2 ? le[16 + c] : le[24 + c]));
        int i1 = 0; float v1 = ls[0];
#pragma unroll
        for (int c = 1; c < 8; ++c) if (ls[c] > v1) { v1 = ls[c]; i1 = c; }
        int i2 = -1; float v2 = -3.0e38f;
#pragma unroll
        for (int c = 0; c < 8; ++c) if (c != i1 && ls[c] > v2) { v2 = ls[c]; i2 = c; }
        const float e2 = expf(v2 - v1); const float w1 = psel / (1.f + e2), w2 = psel * e2 / (1.f + e2);
        if (lane == 0) { const int ea = gs * 8 + i1, eb = gs * 8 + i2;
            const int sa = (int)atomicAdd(cnt + ea, 1u), sb = (int)atomicAdd(cnt + eb, 1u);
            TOK[ea * CAP + sa] = row; TOK[eb * CAP + sb] = row;
            int* r = ROUTE + (size_t)row * 8; r[0] = ea; r[1] = eb; r[2] = sa; r[3] = sb; ((float*)r)[4] = w1; ((float*)r)[5] = w2; }
    }
}

__global__ void __launch_bounds__(256) k_final(float* __restrict__ OUT, const bf16* __restrict__ Y, const int* __restrict__ ROUTE, const unsigned* __restrict__ cnt, const float* __restrict__ gf) {
    const int lane = threadIdx.x & 63; const int gw = (blockIdx.x * blockDim.x + threadIdx.x) >> 6, NGW = (gridDim.x * blockDim.x) >> 6;
    int tiles = lane < NEXP ? (int)((cnt[lane] + 255u) >> 8) : 0; int incl = tiles;
#pragma unroll
    for (int o = 1; o < 32; o <<= 1) { const int n = __shfl_up(incl, o); if (lane >= o) incl += n; }
    const int cbase = (incl - tiles) * 256;
    for (int row = gw; row < M; row += NGW) {
        const int* r = ROUTE + (size_t)row * 8; const int ea = r[0], eb = r[1], sa = r[2], sb = r[3]; const float w1 = ((const float*)r)[4], w2 = ((const float*)r)[5];
        const int pa = __shfl(cbase, ea) + sa, pb = __shfl(cbase, eb) + sb;
        f32x4* xr = (f32x4*)(OUT + (size_t)row * DM) + lane; const u32x2* ya = (const u32x2*)(Y + (size_t)pa * DM) + lane; const u32x2* yb = (const u32x2*)(Y + (size_t)pb * DM) + lane; const f32x4* gr = (const f32x4*)gf + lane;
        f32x4 v[4]; float s = 0.f;
#pragma unroll
        for (int j = 0; j < 4; ++j) { v[j] = xr[64 * j]; const u32x2 a = ya[64 * j], b = yb[64 * j];
            v[j].x += w1 * bflo(a.x) + w2 * bflo(b.x); v[j].y += w1 * bfhi(a.x) + w2 * bfhi(b.x); v[j].z += w1 * bflo(a.y) + w2 * bflo(b.y); v[j].w += w1 * bfhi(a.y) + w2 * bfhi(b.y);
            s += (v[j].x * v[j].x + v[j].y * v[j].y) + (v[j].z * v[j].z + v[j].w * v[j].w); }
        const float rinv = 1.0f / sqrtf(wave_sum(s) * (1.f / DM) + EPS);
#pragma unroll
        for (int j = 0; j < 4; ++j) { const f32x4 g = gr[64 * j]; f32x4 o; o.x = v[j].x * rinv * g.x; o.y = v[j].y * rinv * g.y; o.z = v[j].z * rinv * g.z; o.w = v[j].w * rinv * g.w; xr[64 * j] = o; }
    }
}

template <class K> static void set_lds(K k) { (void)hipFuncSetAttribute((const void*)k, hipFuncAttributeMaxDynamicSharedMemorySize, LDS_BYTES); }

extern "C" void kernel_launch(void* const* d_in, const int* in_sizes, int n_in, void* d_out, int out_size, void* d_ws, size_t ws_size, hipStream_t stream) {
    static int grid = 0;
    if (grid == 0) {
        if (n_in != 20 || out_size != M * DM || ws_size < WS_END) { fprintf(stderr, "kernel_launch: unexpected shapes (n_in %d out %d ws %zu)\n", n_in, out_size, ws_size); grid = -1; return; }
        int dev = 0, cus = 0; if (hipGetDevice(&dev) != hipSuccess || hipDeviceGetAttribute(&cus, hipDeviceAttributeMultiprocessorCount, dev) != hipSuccess) { grid = -1; return; }
        set_lds(k_prologue); set_lds(k_gemm<EpiProj>); set_lds(k_gemm<EpiGate<false>>); set_lds(k_gemm<EpiGate<true>>); set_lds(k_gemm<EpiResid>); set_lds(k_gemm_moe<EpiSwiglu>); set_lds(k_gemm_moe<EpiPlain>);
        (void)hipGetLastError();
        grid = cus;
    }
    if (grid < 0) return;
    unsigned char* ws = (unsigned char*)d_ws;
    (void)hipMemsetAsync(ws + WS_CTL, 0, CTL_ZERO_BYTES, stream);
    P p{}; for (int i = 0; i < 20; ++i) p.in[i] = (const float*)d_in[i]; p.out = (float*)d_out; p.ws = ws;
    bf16* PROJ = (bf16*)(ws + WS_PROJ); bf16* H = (bf16*)(ws + WS_H); unsigned* cnt = (unsigned*)(ws + WS_CTL) + CW_CNT;
    float* AF = (float*)(ws + WS_AF); float* BF = (float*)d_out;
    hipLaunchKernelGGL(k_prologue, dim3(grid), dim3(512), LDS_BYTES, stream, p);
    { pg8::Gemm g{H, (const bf16*)(ws + WS_WIN), M, INW, 1024, 0}; EpiProj E{PROJ}; hipLaunchKernelGGL(k_gemm<EpiProj>, dim3(grid), dim3(512), LDS_BYTES, stream, g, E); }
    hipLaunchKernelGGL(k_attn_simple, dim3(2048), dim3(256), 0, stream, (const bf16*)PROJ, p.in[1], (bf16*)(ws + WS_ATT));
    hipLaunchKernelGGL(k_lru_gates_simple, dim3(2048), dim3(256), 0, stream, (const bf16*)PROJ, p, AF, BF);
    hipLaunchKernelGGL(k_lru_scan_local, dim3(512), dim3(256), 0, stream, (const float*)AF, (const float*)BF, (bf16*)(ws + WS_HL), (bf16*)(ws + WS_PC), (float*)(ws + WS_AGG));
    hipLaunchKernelGGL(k_lru_fixup, dim3(512), dim3(256), 0, stream, (const bf16*)(ws + WS_HL), (const bf16*)(ws + WS_PC), (const float*)(ws + WS_AGG), (const bf16*)PROJ, (bf16*)(ws + WS_LRUO));
    { pg8::Gemm g{(const bf16*)(ws + WS_ATT), (const bf16*)(ws + WS_WPA), M, 1024, 256, 0}; EpiGate<false> E{(bf16*)(ws + WS_PAG), PROJ, nullptr, C_GM, 0}; hipLaunchKernelGGL(k_gemm<EpiGate<false>>, dim3(grid), dim3(512), LDS_BYTES, stream, g, E); }
    { pg8::Gemm g{(const bf16*)(ws + WS_LRUO), (const bf16*)(ws + WS_WPL), M, 1024, 1024, 0}; EpiGate<true> E{(bf16*)(ws + WS_MERGED), PROJ, (const bf16*)(ws + WS_PAG), C_GM + 1024, 0}; hipLaunchKernelGGL(k_gemm<EpiGate<true>>, dim3(grid), dim3(512), LDS_BYTES, stream, g, E); }
    { pg8::Gemm g{(const bf16*)(ws + WS_MERGED), (const bf16*)(ws + WS_WOUT), M, 1024, 1024, 0}; EpiResid E{(float*)d_out, p.in[0]}; hipLaunchKernelGGL(k_gemm<EpiResid>, dim3(grid), dim3(512), LDS_BYTES, stream, g, E); }
    hipLaunchKernelGGL(k_router_simple, dim3(1024), dim3(256), 0, stream, (const float*)d_out, p, H, (int*)(ws + WS_ROUTE), (int*)(ws + WS_TOK), cnt);
    { pg8::Gemm g{H, (const bf16*)(ws + WS_WGU), MAXTILES * 256, 1024, 1024, 0}; EpiSwiglu E{(bf16*)(ws + WS_ACT)}; MoeArgs ma{(const unsigned*)cnt, (const int*)(ws + WS_TOK), (size_t)1024 * 1024 * 2, 1, 0};
      hipLaunchKernelGGL(k_gemm_moe<EpiSwiglu>, dim3(grid), dim3(512), LDS_BYTES, stream, g, E, ma); }
    { pg8::Gemm g{(const bf16*)(ws + WS_ACT), (const bf16*)(ws + WS_WD), MAXTILES * 256, 1024, 512, 0}; EpiPlain E{(bf16*)(ws + WS_Y), 1024, 0}; MoeArgs ma{(const unsigned*)cnt, (const int*)(ws + WS_TOK), (size_t)1024 * 512 * 2, 0, 0};
      hipLaunchKernelGGL(k_gemm_moe<EpiPlain>, dim3(grid), dim3(512), LDS_BYTES, stream, g, E, ma); }
    hipLaunchKernelGGL(k_final, dim3(1024), dim3(256), 0, stream, (float*)d_out, (const bf16*)(ws + WS_Y), (const int*)(ws + WS_ROUTE), (const unsigned*)cnt, p.in[19]);
}
```

```cpp
#include <hip/hip_runtime.h>
#include <cstdio>
#include <cstdint>

__device__ __forceinline__ int fresh_tid() { int t = (int)threadIdx.x; asm volatile("" : "+v"(t)); return t; }
namespace pg8 {
#define PG8_LAS __attribute__((address_space(3)))
typedef unsigned short bf16_t;
typedef short bf16x8 __attribute__((ext_vector_type(8)));
typedef float f32x4 __attribute__((ext_vector_type(4)));
typedef float f32x2 __attribute__((ext_vector_type(2)));
typedef unsigned u32x4 __attribute__((ext_vector_type(4)));
typedef unsigned u32x2 __attribute__((ext_vector_type(2)));
constexpr int BM = 256, BK = 64, HALF = 128, HTB = HALF * BK * 2  , STAGE_BYTES = 8 * HTB, NXCD = 8, WGM = 8;

__host__ __device__ __forceinline__ int lds_byte(int r, int c) { const int st = (r >> 4) * 2 + (c >> 5), rr = r & 15, cc = c & 31, ob = rr * 64 + cc * 2; return st * 1024 + (ob ^ (((ob >> 9) & 1) << 5)); }
__host__ __device__ __forceinline__ void stage_rc(int b, int& R, int& C) { const int st = b / 1024, sb = b % 1024, swz = sb ^ (((sb >> 9) & 1) << 5); R = (st >> 1) * 16 + swz / 64; C = (st & 1) * 32 + (swz % 64) / 2; }
__host__ __device__ __forceinline__ int perm32(int rho) { const int n = rho >> 4, i = rho & 15; return 8 * (i >> 2) + 4 * n + (i & 3); }

struct Unit { int pm, pn, e, r0; };
struct Gemm { const bf16_t* A; const bf16_t* Bt; int M, N, K, pad; };

struct StaticOrder {
    int nM, nN, nwg, G, c, rb;
    __host__ __device__ void init(int M, int N, int rb_, int G_, int c_) { nM = M / BM; nN = N / BM; nwg = nM * nN; G = G_; c = c_; rb = rb_; }
    __device__ __forceinline__ bool next(int i, Unit& u) const {
        const long L = (long)i * G + c; if (L >= nwg) return false;
        int wgid = (int)L; { const int q = nwg / NXCD, r = nwg % NXCD, xcd = wgid % NXCD, off = wgid / NXCD; wgid = (xcd < r ? xcd * (q + 1) : r * (q + 1) + (xcd - r) * q) + off; }
        const int nig = WGM * nN, gid = wgid / nig, fm = gid * WGM, gsz = (nM - fm) < WGM ? (nM - fm) : WGM;
        u.pm = fm + ((wgid % nig) % gsz); u.pn = (wgid % nig) / gsz; u.e = 0; u.r0 = 0; return true;
    }
    __device__ __forceinline__ unsigned a_off(const Unit& u, int r) const { return (unsigned)(u.pm * BM + r) * (unsigned)rb; }
    __device__ __forceinline__ size_t b_off(const Unit& u) const { return (size_t)u.pn * BM * rb; }
    static constexpr int A_AUX = 0; static constexpr bool HANDOFF = false;
    __device__ __forceinline__ unsigned poll_begin(const Unit&) const { return 0u; }
    __device__ __forceinline__ void poll_end(const Unit&, unsigned) const {}
    __device__ __forceinline__ void publish(int) const {}
};

__device__ __forceinline__ unsigned cvt_pk_bf16(float lo, float hi) { unsigned r; asm volatile("v_cvt_pk_bf16_f32 %0, %1, %2" : "=v"(r) : "v"(lo), "v"(hi)); return r; }

typedef int i32x8 __attribute__((ext_vector_type(8)));
template <class Epi, class Sched, bool FP8 = false, bool ALIGN_EPI = false, bool SP2 = false>
__device__ __forceinline__ void gemm_phase(PG8_LAS unsigned char* lds, const Gemm g, const Sched& S, const Epi& E) {
    const int tid = fresh_tid(), wid = __builtin_amdgcn_readfirstlane(tid >> 6), lane = tid & 63, wr = wid >> 2, wc = wid & 3, fr = lane & 15, fq = lane >> 4;
    const int RB = FP8 ? g.K : g.K * 2, nt = RB / (BK * 2);
    unsigned voffB[2];
#pragma unroll
    for (int i = 0; i < 2; ++i) { int R, C; stage_rc(tid * 16 + i * 8192, R, C); const int Rb = Epi::PERM ? ((R & ~31) + perm32(R & 31)) : R;
        voffB[i] = (unsigned)(Rb * RB + C * 2); }
#define PG8_AOFFS(U, A0, A1) do { const int _t = fresh_tid(); _Pragma("unroll") for (int i = 0; i < 2; ++i) { int R, C; stage_rc(_t * 16 + i * 8192, R, C); A0[i] = S.a_off(U, R) + (unsigned)C * 2u; A1[i] = S.a_off(U, HALF + R) + (unsigned)C * 2u; } } while (0)
    const size_t kstep = (size_t)(BK * 2);
    const size_t hstep = (size_t)HALF * RB;
    const unsigned ldsw = (unsigned)wid * 1024u;
    const int aoff = lds_byte(wr * 64 + fr, fq * 8), boff = lds_byte(wc * 32 + fr, fq * 8);
    const int aoff8 = lds_byte(wr * 64 + fr, fq * 16), boff8 = lds_byte(wc * 32 + fr, fq * 16);
#define PG8_SA(b, h) (((b) * 2 + (h)) * HTB)
#define PG8_SB(b, h) ((4 + (b) * 2 + (h)) * HTB)
#define PG8_STAGE(bufoff, gbase, voff) do { _Pragma("unroll") for (int _i = 0; _i < 2; ++_i) \
        __builtin_amdgcn_global_load_lds((const unsigned*)((const char*)(gbase) + (voff)[_i]), (PG8_LAS unsigned*)(lds + (bufoff) + ldsw + _i * 8192), 16, 0, 0); } while (0)
#define PG8_STAGE_A(bufoff, gbase, voff) do { _Pragma("unroll") for (int _i = 0; _i < 2; ++_i) \
        __builtin_amdgcn_global_load_lds((const unsigned*)((const char*)(gbase) + (voff)[_i]), (PG8_LAS unsigned*)(lds + (bufoff) + ldsw + _i * 8192), 16, 0, Sched::A_AUX); } while (0)
#define PG8_LDA(dst, b, h) do { if constexpr (FP8) { _Pragma("unroll") for (int m = 0; m < 4; ++m) dst##8[m] = *(const PG8_LAS i32x8*)(lds + PG8_SA(b, h) + aoff8 + m * 2048); } \
        else { _Pragma("unroll") for (int m = 0; m < 4; ++m) _Pragma("unroll") for (int k = 0; k < 2; ++k) dst[m][k] = *(const PG8_LAS bf16x8*)(lds + PG8_SA(b, h) + aoff + m * 2048 + k * 1024); } } while (0)
#define PG8_LDB(dst, b, h) do { if constexpr (FP8) { _Pragma("unroll") for (int n = 0; n < 2; ++n) dst##8[n] = *(const PG8_LAS i32x8*)(lds + PG8_SB(b, h) + boff8 + n * 2048); } \
        else { _Pragma("unroll") for (int n = 0; n < 2; ++n) _Pragma("unroll") for (int k = 0; k < 2; ++k) dst[n][k] = *(const PG8_LAS bf16x8*)(lds + PG8_SB(b, h) + boff + n * 2048 + k * 1024); } } while (0)
#define PG8_MMA(ai, bj, At, Bt) do { __builtin_amdgcn_s_setprio(1); if constexpr (FP8) { _Pragma("unroll") for (int m = 0; m < 4; ++m) _Pragma("unroll") for (int n = 0; n < 2; ++n) \
            asm volatile("v_mfma_f32_16x16x128_f8f6f4 %0, %1, %2, %0" : "+v"(acc[ai][bj][m][n]) : "v"(Bt##8[n]), "v"(At##8[m]));     } \
        else { _Pragma("unroll") for (int m = 0; m < 4; ++m) _Pragma("unroll") for (int n = 0; n < 2; ++n) _Pragma("unroll") for (int k = 0; k < 2; ++k) \
            acc[ai][bj][m][n] = __builtin_amdgcn_mfma_f32_16x16x32_bf16(Bt[n][k], At[m][k], acc[ai][bj][m][n], 0, 0, 0); } __builtin_amdgcn_s_setprio(0); } while (0)
#define PG8_STAGE_SEL(bufoff, gbase, va, vb) do { _Pragma("unroll") for (int _i = 0; _i < 2; ++_i) \
        __builtin_amdgcn_global_load_lds((const unsigned*)((const char*)(gbase) + (last ? (vb)[_i] : (va)[_i])), (PG8_LAS unsigned*)(lds + (bufoff) + ldsw + _i * 8192), 16, 0, Sched::A_AUX); } while (0)
#define PG8_WAIT_V(n) asm volatile("s_waitcnt vmcnt(" #n ")" ::: "memory")
#define PG8_WAIT_L(n) asm volatile("s_waitcnt lgkmcnt(" #n ")" ::: "memory")
#define PG8_BAR __builtin_amdgcn_s_barrier()
#define PG8_SCHED __builtin_amdgcn_sched_barrier(0)
    Unit cur, nxt; int ui = 0;
    if (!S.next(0, cur)) return;
    f32x4 acc[2][2][4][2];
#pragma unroll
    for (int a = 0; a < 2; ++a)
#pragma unroll
        for (int b = 0; b < 2; ++b)
#pragma unroll
            for (int m = 0; m < 4; ++m)
#pragma unroll
                for (int n = 0; n < 2; ++n) acc[a][b][m][n] = (f32x4){0.f, 0.f, 0.f, 0.f};
    bf16x8 At[4][2], B0[2][2], B1[2][2]; i32x8 At8[4], B08[2], B18[2];
    unsigned cA0[2], cA1[2], nA0[2], nA1[2];
    PG8_AOFFS(cur, cA0, cA1);
    const char* gA = (const char*)g.A;
    const char* cB = (const char*)g.Bt + S.b_off(cur);
    S.poll_end(cur, S.poll_begin(cur));
    int pend = -1;
    if constexpr (SP2) {
        PG8_STAGE(PG8_SB(0, 0), cB, voffB); PG8_STAGE(PG8_SB(0, 1), cB + hstep, voffB); PG8_STAGE_A(PG8_SA(0, 0), gA, cA0); PG8_STAGE_A(PG8_SA(0, 1), gA, cA1);
        if (wr == 1) PG8_BAR;
        PG8_WAIT_V(2); PG8_BAR;
        PG8_STAGE(PG8_SB(1, 0), cB + kstep, voffB); PG8_STAGE_A(PG8_SA(1, 0), gA + kstep, cA0); PG8_STAGE(PG8_SB(1, 1), cB + hstep + kstep, voffB);
        PG8_WAIT_V(6); PG8_BAR;
    } else {
    PG8_STAGE(PG8_SB(0, 0), cB, voffB); PG8_STAGE_A(PG8_SA(0, 0), gA, cA0); PG8_STAGE(PG8_SB(0, 1), cB + hstep, voffB); PG8_STAGE_A(PG8_SA(0, 1), gA, cA1);
    if (wr == 1) PG8_BAR;
    PG8_WAIT_V(4); PG8_BAR;
    PG8_STAGE(PG8_SB(1, 0), cB + kstep, voffB); PG8_STAGE_A(PG8_SA(1, 0), gA + kstep, cA0); PG8_STAGE(PG8_SB(1, 1), cB + hstep + kstep, voffB);
    PG8_WAIT_V(6); PG8_BAR;
    }
    for (;;) {
        const bool has_next = S.next(ui + 1, nxt);
        const char* nB = has_next ? (const char*)g.Bt + S.b_off(nxt) : cB;
        const unsigned pv = has_next ? S.poll_begin(nxt) : 0u;
        if (has_next) { PG8_AOFFS(nxt, nA0, nA1);
        } else {
#pragma unroll
            for (int i = 0; i < 2; ++i) { nA0[i] = cA0[i]; nA1[i] = cA1[i]; }
        }
        for (int t = 0; t < nt; t += 2) {
            const bool last = (t == nt - 2);
            if constexpr (Epi::MID_T > 0) { if (t == Epi::MID_T) E.mid(acc, cur, wr, wc, fr, fq); }
            if constexpr (Sched::HANDOFF) if (last && has_next) S.poll_end(nxt, pv);
            const char* a1 = gA + (size_t)(t + 1) * kstep;
            const char* a2 = last ? gA : gA + (size_t)(t + 2) * kstep; const char* b2 = last ? nB : cB + (size_t)(t + 2) * kstep;
            const char* a3 = a2 + kstep; const char* b3 = b2 + kstep;
            if constexpr (SP2) {
            PG8_LDB(B0, 0, 0); PG8_LDB(B1, 0, 1); PG8_SCHED; PG8_LDA(At, 0, 0); PG8_STAGE_A(PG8_SA(1, 1), a1, cA1);
            PG8_WAIT_V(8); if constexpr (Sched::HANDOFF) if (t == 2 && pend >= 0) { S.publish(pend); pend = -1; }
            PG8_WAIT_L(0); PG8_BAR; PG8_MMA(0, 0, At, B0); PG8_MMA(0, 1, At, B1); PG8_BAR; PG8_SCHED;
            PG8_LDA(At, 0, 1); PG8_STAGE(PG8_SB(0, 0), b2, voffB); PG8_STAGE(PG8_SB(0, 1), b2 + hstep, voffB); PG8_STAGE_SEL(PG8_SA(0, 0), a2, cA0, nA0);
            PG8_WAIT_V(8); PG8_WAIT_L(0); PG8_BAR; PG8_MMA(1, 0, At, B0); PG8_MMA(1, 1, At, B1); PG8_BAR; PG8_SCHED;
            PG8_LDB(B0, 1, 0); PG8_LDB(B1, 1, 1); PG8_SCHED; PG8_LDA(At, 1, 0); PG8_STAGE_SEL(PG8_SA(0, 1), a2, cA1, nA1);
            PG8_WAIT_V(8); PG8_WAIT_L(0); PG8_BAR; PG8_MMA(0, 0, At, B0); PG8_MMA(0, 1, At, B1); PG8_BAR; PG8_SCHED;
            PG8_LDA(At, 1, 1); PG8_STAGE(PG8_SB(1, 0), b3, voffB); PG8_STAGE(PG8_SB(1, 1), b3 + hstep, voffB); PG8_STAGE_SEL(PG8_SA(1, 0), a3, cA0, nA0);
            PG8_WAIT_V(8); PG8_WAIT_L(0); PG8_BAR; PG8_MMA(1, 0, At, B0); PG8_MMA(1, 1, At, B1); PG8_BAR; PG8_SCHED;
            } else {
            PG8_LDB(B0, 0, 0); PG8_SCHED; PG8_LDA(At, 0, 0); PG8_STAGE_A(PG8_SA(1, 1), a1, cA1);
            PG8_WAIT_L(8); PG8_BAR; PG8_WAIT_L(0); PG8_MMA(0, 0, At, B0); PG8_BAR; PG8_SCHED;
            PG8_LDB(B1, 0, 1); PG8_STAGE(PG8_SB(0, 0), b2, voffB);
            PG8_BAR; PG8_WAIT_L(0); PG8_MMA(0, 1, At, B1); PG8_BAR;
            PG8_LDA(At, 0, 1); PG8_STAGE_SEL(PG8_SA(0, 0), a2, cA0, nA0);
            PG8_BAR; PG8_WAIT_L(0); PG8_MMA(1, 0, At, B0); PG8_BAR; PG8_SCHED;
            PG8_STAGE(PG8_SB(0, 1), b2 + hstep, voffB);
            PG8_WAIT_V(6); PG8_BAR; PG8_MMA(1, 1, At, B1); PG8_BAR;
            PG8_LDB(B0, 1, 0); PG8_SCHED; PG8_LDA(At, 1, 0); PG8_STAGE_SEL(PG8_SA(0, 1), a2, cA1, nA1);
            PG8_WAIT_L(8); PG8_BAR; PG8_WAIT_L(0); PG8_MMA(0, 0, At, B0); PG8_BAR; PG8_SCHED;
            PG8_LDB(B1, 1, 1); PG8_STAGE(PG8_SB(1, 0), b3, voffB);
            PG8_BAR; PG8_WAIT_L(0); PG8_MMA(0, 1, At, B1); PG8_BAR;
            PG8_LDA(At, 1, 1); PG8_STAGE_SEL(PG8_SA(1, 0), a3, cA0, nA0);
            PG8_BAR; PG8_WAIT_L(0); PG8_MMA(1, 0, At, B0); PG8_BAR; PG8_SCHED;
            PG8_STAGE(PG8_SB(1, 1), b3 + hstep, voffB);
            PG8_WAIT_V(6); PG8_BAR; PG8_MMA(1, 1, At, B1); PG8_BAR;
            }
        }
        if constexpr (ALIGN_EPI) { if (wr == 0) PG8_BAR; }
        if constexpr (FP8) asm volatile("s_nop 15\n\ts_nop 15" ::: "memory");
        E(acc, cur, wr, wc, fr, fq);
        if constexpr (Sched::HANDOFF) { if (pend >= 0) { PG8_WAIT_V(0); S.publish(pend); } pend = cur.pm; }
        if (!has_next) break;
#pragma unroll
        for (int a = 0; a < 2; ++a)
#pragma unroll
            for (int b = 0; b < 2; ++b)
#pragma unroll
                for (int m = 0; m < 4; ++m)
#pragma unroll
                    for (int n = 0; n < 2; ++n) acc[a][b][m][n] = (f32x4){0.f, 0.f, 0.f, 0.f};
        cur = nxt; cB = nB; ++ui;
#pragma unroll
        for (int i = 0; i < 2; ++i) { cA0[i] = nA0[i]; cA1[i] = nA1[i]; }
        if constexpr (ALIGN_EPI) { if (wr == 1) PG8_BAR; }
    }
    PG8_WAIT_V(0);
    if constexpr (Sched::HANDOFF) S.publish(pend);
    if constexpr (!ALIGN_EPI) { if (wr == 0) PG8_BAR; }
    PG8_BAR;
#undef PG8_SA
#undef PG8_SB
#undef PG8_STAGE
#undef PG8_STAGE_A
#undef PG8_STAGE_SEL
#undef PG8_AOFFS
#undef PG8_LDA
#undef PG8_LDB
#undef PG8_MMA
#undef PG8_WAIT_V
#undef PG8_WAIT_L
#undef PG8_BAR
#undef PG8_SCHED
}
}

#define GAS __attribute__((address_space(1)))
#define LAS __attribute__((address_space(3)))
typedef unsigned short bf16;
typedef pg8::f32x4 f32x4;
typedef pg8::f32x2 f32x2;
typedef pg8::u32x4 u32x4;
typedef pg8::u32x2 u32x2;
typedef pg8::bf16x8 bf16x8;
using pg8::cvt_pk_bf16;

constexpr int SEQ = 8192, DM = 1024, M = 2 * SEQ;
constexpr int INW = 6400, C_K = 768, C_V = 1536, C_XR = 2304, C_GL = 3328, C_GM = 4352;
constexpr int NEXP = 32, DEXP = 512, CAP = 16384, MAXTILES = 160;
constexpr float EPS = 1e-6f;
constexpr int NWAVES = 8;
constexpr int LDS_BYTES = 147456;
constexpr int TAB_OFF = 131072 + 1024;

constexpr size_t MiB = 1u << 20;
constexpr size_t WS_CTL = 0, CTL_ZERO_BYTES = 32 * 1024;
constexpr size_t WS_WIN = 2 * MiB;
constexpr size_t WS_WOUT = 18 * MiB;
constexpr size_t WS_WRT = 15 * MiB + 512 * 1024;
constexpr size_t WS_WGU = 20 * MiB;
constexpr size_t WS_WD = 84 * MiB;
constexpr size_t WS_H = 116 * MiB;
constexpr size_t WS_PROJ = 148 * MiB;
constexpr size_t WS_ACT = WS_PROJ, WS_Y = WS_PROJ + 40 * MiB;
constexpr size_t WS_HL = 348 * MiB;
constexpr size_t WS_WPLA = 103 * MiB;
constexpr size_t WS_CA = 413 * MiB;
constexpr int CAW = 1280;
constexpr size_t WS_X1B = WS_HL;
constexpr size_t WS_MERGED = 52 * MiB;
constexpr size_t WS_PC = 380 * MiB;
constexpr size_t WS_DELTA = 479 * MiB;
constexpr size_t WS_AGG = 412 * MiB;
constexpr size_t WS_ROUTE = 100 * MiB;
constexpr size_t WS_TOK = 101 * MiB;
constexpr size_t WS_OG = 453 * MiB;
constexpr size_t WS_LSE = 477 * MiB;
constexpr size_t WS_END = 512 * MiB;
constexpr int CW_CNT = 64;

__device__ __forceinline__ float bf2f(unsigned short b) { return __uint_as_float(((unsigned)b) << 16); }
__device__ __forceinline__ float bflo(unsigned w) { return __uint_as_float(w << 16); }
__device__ __forceinline__ float bfhi(unsigned w) { return __uint_as_float(w & 0xffff0000u); }
__device__ __forceinline__ unsigned short f2bf(float f) { return (unsigned short)(cvt_pk_bf16(f, 0.f) & 0xffffu); }
__device__ __forceinline__ float wave_sum(float v) {
#pragma unroll
    for (int o = 1; o < 64; o <<= 1) v += __shfl_xor(v, o);
    return v;
}
__device__ __forceinline__ float wave_max(float v) {
#pragma unroll
    for (int o = 1; o < 64; o <<= 1) v = fmaxf(v, __shfl_xor(v, o));
    return v;
}
__device__ __forceinline__ unsigned pk4_fp8(float a, float b, float c, float d) { int w = 0; w = __builtin_amdgcn_cvt_pk_fp8_f32(a, b, w, false); w = __builtin_amdgcn_cvt_pk_fp8_f32(c, d, w, true); return (unsigned)w; }
constexpr float WSCALE = 32.0f, WINV = 1.0f / 32.0f;
__device__ __forceinline__ void lds_barrier() { asm volatile("s_waitcnt lgkmcnt(0)\n\ts_barrier" ::: "memory"); }
__device__ __forceinline__ void st_wt16(void* p, u32x4 v) { asm volatile("global_store_dwordx4 %0, %1, off sc1\n\ts_nop 1" :: "v"(p), "v"(v) : "memory"); }
__device__ __forceinline__ int team_rows64(int c) { const int x = c & 7, off = c >> 3; return 32 * x + 4 * (off & 7) + (off >> 3); }
__device__ __forceinline__ float sigmoid_f(float x) { return __builtin_amdgcn_rcpf(1.0f + __builtin_amdgcn_exp2f(-1.4426950408889634f * x)); }
__device__ __forceinline__ float gelu_tanh_f(float x) { const float u = 0.7978845608028654f * (x + 0.044715f * x * x * x); return x * sigmoid_f(2.0f * u); }

__device__ const unsigned char BUCKET[3][132] = {
 {0,1,2,3,4,5,6,7,8,9,10,11,12,13,14,15,16,16,16,16,16,16,17,17,17,17,17,17,17,17,18,18,18,18,18,18,18,18,18,18,19,19,19,19,19,19,19,19,19,19,19,19,19,19,20,20,20,20,20,20,20,20,20,20,20,20,20,20,20,20,20,20,20,21,21,21,21,21,21,21,21,21,21,21,21,21,21,21,21,21,21,21,21,21,21,21,21,21,21,22,22,22,22,22,22,22,22,22,22,22,22,22,22,22,22,22,22,22,22,22,22,22,22,22,22,22,22,22,22,0,0,0},
 {0,4,8,12,16,16,17,17,18,18,19,19,19,19,20,20,20,20,20,21,21,21,21,21,21,22,22,22,22,22,22,22,22,22,23,23,23,23,23,23,23,23,23,23,23,23,24,24,24,24,24,24,24,24,24,24,24,24,24,24,24,24,25,25,25,25,25,25,25,25,25,25,25,25,25,25,25,25,25,25,25,25,25,26,26,26,26,26,26,26,26,26,26,26,26,26,26,26,26,26,26,26,26,26,26,26,26,26,26,26,26,26,26,27,27,27,27,27,27,27,27,27,27,27,27,27,27,27,27,0,0,0},
 {0,16,18,19,20,21,21,22,22,23,23,23,24,24,24,24,25,25,25,25,25,26,26,26,26,26,26,26,26,27,27,27,27,27,27,27,27,27,27,28,28,28,28,28,28,28,28,28,28,28,28,28,29,29,29,29,29,29,29,29,29,29,29,29,29,29,29,29,29,29,30,30,30,30,30,30,30,30,30,30,30,30,30,30,30,30,30,30,30,30,30,30,30,30,30,31,31,31,31,31,31,31,31,31,31,31,31,31,31,31,31,31,31,31,31,31,31,31,31,31,31,31,31,31,31,31,31,31,31,0,0,0}};

__device__ __forceinline__ u32x4 pair16(u32x2 a, u32x2 b) {
    const auto x = __builtin_amdgcn_permlane16_swap(a.x, b.x, false, false), y = __builtin_amdgcn_permlane16_swap(a.y, b.y, false, false);
    u32x4 r; r.x = x[0]; r.y = y[0]; r.z = x[1]; r.w = y[1]; return r;
}
__device__ __forceinline__ float sig255(float t) { return __builtin_amdgcn_rcpf(__builtin_fmaf(__builtin_amdgcn_exp2f(t), 1.0f / 255.0f, 1.0f / 255.0f)); }
__device__ __forceinline__ unsigned pk4_u8(float a, float b, float c, float d) {
    unsigned r = __builtin_amdgcn_cvt_pk_u8_f32(__builtin_rintf(a), 0, 0u); r = __builtin_amdgcn_cvt_pk_u8_f32(__builtin_rintf(b), 1, r);
    r = __builtin_amdgcn_cvt_pk_u8_f32(__builtin_rintf(c), 2, r); return __builtin_amdgcn_cvt_pk_u8_f32(__builtin_rintf(d), 3, r);
}
__device__ __forceinline__ float ub0(unsigned w) { return (float)(w & 0xffu); }
__device__ __forceinline__ float ub1(unsigned w) { return (float)((w >> 8) & 0xffu); }
__device__ __forceinline__ float ub2(unsigned w) { return (float)((w >> 16) & 0xffu); }
__device__ __forceinline__ float ub3(unsigned w) { return (float)(w >> 24); }
struct EpiProj {
    static constexpr bool PERM = true; static constexpr int MID_T = 0;
    bf16* O;
    __device__ __forceinline__ void operator()(const f32x4 (&acc)[2][2][4][2], const pg8::Unit& u, int wr, int wc, int fr, int fq) const {
        const int row0 = u.pm * 256 + wr * 64 + fr, col0 = u.pn * 256 + wc * 32 + 8 * fq;
        const int mode = u.pn < 3 ? 0 : (u.pn < 17 ? 1 : 3);
        if (mode == 3) {
            const int rowq = row0 + (fq & 1) * 16, cq = (u.pn - 17) * 256 + wc * 32 + 8 * (fq & 2);
#pragma unroll
            for (int ai = 0; ai < 2; ++ai)
#pragma unroll
                for (int mp = 0; mp < 2; ++mp) { unsigned char* rowp = (unsigned char*)(O + (size_t)(rowq + ai * 128 + mp * 32) * INW + C_GM) + cq;
#pragma unroll
                    for (int bj = 0; bj < 2; ++bj) { u32x2 w[2];
#pragma unroll
                        for (int mm = 0; mm < 2; ++mm) { const f32x4 v0 = acc[ai][bj][2 * mp + mm][0], v1 = acc[ai][bj][2 * mp + mm][1];
                            w[mm].x = pk4_u8(sig255(v0[0]), sig255(v0[1]), sig255(v0[2]), sig255(v0[3])); w[mm].y = pk4_u8(sig255(v1[0]), sig255(v1[1]), sig255(v1[2]), sig255(v1[3])); }
                        *(u32x4*)(rowp + bj * 128) = pair16(w[0], w[1]); } }
            return; }
#pragma unroll
        for (int ai = 0; ai < 2; ++ai)
#pragma unroll
            for (int m = 0; m < 4; ++m) { bf16* rowp = O + (size_t)(row0 + ai * 128 + m * 16) * INW + col0;
#pragma unroll
                for (int bj = 0; bj < 2; ++bj) { f32x4 v0 = acc[ai][bj][m][0], v1 = acc[ai][bj][m][1];
                    if (mode == 2) {
#pragma unroll
                        for (int j = 0; j < 4; ++j) { v0[j] = gelu_tanh_f(v0[j]); v1[j] = gelu_tanh_f(v1[j]); } }
                    u32x4 w; w.x = cvt_pk_bf16(v0[0], v0[1]); w.y = cvt_pk_bf16(v0[2], v0[3]); w.z = cvt_pk_bf16(v1[0], v1[1]); w.w = cvt_pk_bf16(v1[2], v1[3]);
                    *(u32x4*)(rowp + bj * 128) = w; } }
    }
};
template <bool HAS_ADD> struct EpiGate {
    static constexpr bool PERM = true; static constexpr int MID_T = 0;
    bf16* O; const bf16* PROJ; const bf16* ADD; int gcol0, pad;
    __device__ __forceinline__ void operator()(const f32x4 (&acc)[2][2][4][2], const pg8::Unit& u, int wr, int wc, int fr, int fq) const {
        const int row0 = u.pm * 256 + wr * 64 + fr, col0 = u.pn * 256 + wc * 32 + 8 * fq;
#pragma unroll
        for (int ai = 0; ai < 2; ++ai) {
            u32x4 gv[4][2], av[4][2];
#pragma unroll
            for (int m = 0; m < 4; ++m)
#pragma unroll
                for (int bj = 0; bj < 2; ++bj) { const size_t r = (size_t)(row0 + ai * 128 + m * 16); const int c = col0 + bj * 128;
                    gv[m][bj] = *(const u32x4*)(PROJ + r * INW + gcol0 + c); if (HAS_ADD) av[m][bj] = *(const u32x4*)(ADD + r * DM + c); }
#pragma unroll
            for (int m = 0; m < 4; ++m)
#pragma unroll
                for (int bj = 0; bj < 2; ++bj) { const size_t r = (size_t)(row0 + ai * 128 + m * 16); const int c = col0 + bj * 128; const u32x4 g = gv[m][bj];
                    f32x4 v0 = acc[ai][bj][m][0], v1 = acc[ai][bj][m][1];
                    v0[0] *= bflo(g.x); v0[1] *= bfhi(g.x); v0[2] *= bflo(g.y); v0[3] *= bfhi(g.y);
                    v1[0] *= bflo(g.z); v1[1] *= bfhi(g.z); v1[2] *= bflo(g.w); v1[3] *= bfhi(g.w);
                    if (HAS_ADD) { const u32x4 a = av[m][bj];
                        v0[0] += bflo(a.x); v0[1] += bfhi(a.x); v0[2] += bflo(a.y); v0[3] += bfhi(a.y);
                        v1[0] += bflo(a.z); v1[1] += bfhi(a.z); v1[2] += bflo(a.w); v1[3] += bfhi(a.w); }
                    u32x4 w; w.x = cvt_pk_bf16(v0[0], v0[1]); w.y = cvt_pk_bf16(v0[2], v0[3]); w.z = cvt_pk_bf16(v1[0], v1[1]); w.w = cvt_pk_bf16(v1[2], v1[3]);
                    *(u32x4*)(O + r * DM + c) = w; }
        }
    }
};
struct EpiGateMid {
    static constexpr bool PERM = true; static constexpr int MID_T = 16;
    bf16* O; const bf16* PROJ; int gcolA, gcolL;
    __device__ __forceinline__ void mid(f32x4 (&acc)[2][2][4][2], const pg8::Unit& u, int wr, int wc, int fr, int fq) const {
        int opq = 0; asm volatile("" : "+v"(opq));
        const int row0 = u.pm * 256 + wr * 64 + fr + opq, col0 = u.pn * 256 + wc * 32 + 8 * fq;
#pragma unroll
        for (int ai = 0; ai < 2; ++ai) {
            u32x2 av[4][2], lv[4][2];
#pragma unroll
            for (int m = 0; m < 4; ++m)
#pragma unroll
                for (int bj = 0; bj < 2; ++bj) { const unsigned char* gp = (const unsigned char*)(PROJ + (size_t)(row0 + ai * 128 + m * 16) * INW + C_GM) + col0 + bj * 128; av[m][bj] = *(const u32x2*)(gp + gcolA); lv[m][bj] = *(const u32x2*)(gp + gcolL); }
#pragma unroll
            for (int m = 0; m < 4; ++m)
#pragma unroll
                for (int bj = 0; bj < 2; ++bj) { const u32x2 a = av[m][bj], l = lv[m][bj];
#define GQ(L, A) ((L) * __builtin_amdgcn_rcpf(fmaxf((A), 1e-28f)))
                    acc[ai][bj][m][0][0] *= GQ(ub0(l.x), ub0(a.x)); acc[ai][bj][m][0][1] *= GQ(ub1(l.x), ub1(a.x)); acc[ai][bj][m][0][2] *= GQ(ub2(l.x), ub2(a.x)); acc[ai][bj][m][0][3] *= GQ(ub3(l.x), ub3(a.x));
                    acc[ai][bj][m][1][0] *= GQ(ub0(l.y), ub0(a.y)); acc[ai][bj][m][1][1] *= GQ(ub1(l.y), ub1(a.y)); acc[ai][bj][m][1][2] *= GQ(ub2(l.y), ub2(a.y)); acc[ai][bj][m][1][3] *= GQ(ub3(l.y), ub3(a.y));
#undef GQ
                }
            asm volatile("" ::: "memory");
        }
    }
    __device__ __forceinline__ void operator()(const f32x4 (&acc)[2][2][4][2], const pg8::Unit& u, int wr, int wc, int fr, int fq) const {
        const int row0 = u.pm * 256 + wr * 64 + fr, col0 = u.pn * 256 + wc * 32 + 8 * fq;
        constexpr float S = 1.0f / 255.0f;
#pragma unroll
        for (int ai = 0; ai < 2; ++ai) {
            u32x2 gv[4][2];
#pragma unroll
            for (int m = 0; m < 4; ++m)
#pragma unroll
                for (int bj = 0; bj < 2; ++bj) gv[m][bj] = *(const u32x2*)((const unsigned char*)(PROJ + (size_t)(row0 + ai * 128 + m * 16) * INW + C_GM) + gcolA + col0 + bj * 128);
#pragma unroll
            for (int m = 0; m < 4; ++m)
#pragma unroll
                for (int bj = 0; bj < 2; ++bj) { const size_t r = (size_t)(row0 + ai * 128 + m * 16); const int c = col0 + bj * 128; const u32x2 g = gv[m][bj];
                    f32x4 v0 = acc[ai][bj][m][0], v1 = acc[ai][bj][m][1];
                    v0[0] *= fmaxf(ub0(g.x), 1e-28f) * S; v0[1] *= fmaxf(ub1(g.x), 1e-28f) * S; v0[2] *= fmaxf(ub2(g.x), 1e-28f) * S; v0[3] *= fmaxf(ub3(g.x), 1e-28f) * S;
                    v1[0] *= fmaxf(ub0(g.y), 1e-28f) * S; v1[1] *= fmaxf(ub1(g.y), 1e-28f) * S; v1[2] *= fmaxf(ub2(g.y), 1e-28f) * S; v1[3] *= fmaxf(ub3(g.y), 1e-28f) * S;
                    u32x4 w; w.x = cvt_pk_bf16(v0[0], v0[1]); w.y = cvt_pk_bf16(v0[2], v0[3]); w.z = cvt_pk_bf16(v1[0], v1[1]); w.w = cvt_pk_bf16(v1[2], v1[3]);
                    st_wt16(O + r * DM + c, w); }
        }
    }
};
struct EpiSwiglu {
    static constexpr bool PERM = true; static constexpr int MID_T = 0;
    unsigned char* O;
    __device__ __forceinline__ void operator()(const f32x4 (&acc)[2][2][4][2], const pg8::Unit& u, int wr, int wc, int fr, int fq) const {
        const int row0 = u.pm * 256 + wr * 64 + fr + (fq & 1) * 16, col0 = u.pn * 128 + wc * 32 + 8 * (fq & 2);
#pragma unroll
        for (int ai = 0; ai < 2; ++ai)
#pragma unroll
            for (int mp = 0; mp < 2; ++mp) { u32x2 w[2];
#pragma unroll
                for (int mm = 0; mm < 2; ++mm) { const int m = 2 * mp + mm; f32x4 v0, v1;
#pragma unroll
                    for (int j = 0; j < 4; ++j) { const float a0 = acc[ai][0][m][0][j], a1 = acc[ai][0][m][1][j];
                        constexpr float IW2 = WSCALE * WSCALE, NL = -WINV * 1.4426950408889634f;
                        v0[j] = a0 * acc[ai][1][m][0][j] * __builtin_amdgcn_rcpf(__builtin_fmaf(__builtin_amdgcn_exp2f(a0 * NL), IW2, IW2));
                        v1[j] = a1 * acc[ai][1][m][1][j] * __builtin_amdgcn_rcpf(__builtin_fmaf(__builtin_amdgcn_exp2f(a1 * NL), IW2, IW2)); }
                    w[mm].x = pk4_fp8(v0[0], v0[1], v0[2], v0[3]); w[mm].y = pk4_fp8(v1[0], v1[1], v1[2], v1[3]); }
                st_wt16(O + (size_t)(row0 + ai * 128 + mp * 32) * DEXP + col0, pair16(w[0], w[1])); }
    }
};
struct EpiPlain {
    static constexpr bool PERM = true; static constexpr int MID_T = 0;
    bf16* O; int ldc; float scale;
    __device__ __forceinline__ void operator()(const f32x4 (&acc)[2][2][4][2], const pg8::Unit& u, int wr, int wc, int fr, int fq) const {
        const int row0 = u.pm * 256 + wr * 64 + fr, col0 = u.pn * 256 + wc * 32 + 8 * fq;
#pragma unroll
        for (int ai = 0; ai < 2; ++ai)
#pragma unroll
            for (int m = 0; m < 4; ++m) { bf16* rowp = O + (size_t)(row0 + ai * 128 + m * 16) * ldc + col0;
#pragma unroll
                for (int bj = 0; bj < 2; ++bj) { const f32x4 v0 = acc[ai][bj][m][0] * scale, v1 = acc[ai][bj][m][1] * scale;
                    u32x4 w; w.x = cvt_pk_bf16(v0[0], v0[1]); w.y = cvt_pk_bf16(v0[2], v0[3]); w.z = cvt_pk_bf16(v1[0], v1[1]); w.w = cvt_pk_bf16(v1[2], v1[3]);
                    st_wt16(rowp + bj * 128, w); } }
    }
};

constexpr float YSCALE = 4.0f, YINV = 0.25f;
struct EpiY8 {
    static constexpr bool PERM = true; static constexpr int MID_T = 0;
    unsigned char* O; float scale;
    __device__ __forceinline__ void operator()(const f32x4 (&acc)[2][2][4][2], const pg8::Unit& u, int wr, int wc, int fr, int fq) const {
        const int row0 = u.pm * 256 + wr * 64 + fr + (fq & 1) * 16, col0 = u.pn * 256 + wc * 32 + 8 * (fq & 2);
#pragma unroll
        for (int ai = 0; ai < 2; ++ai)
#pragma unroll
            for (int mp = 0; mp < 2; ++mp) { unsigned char* rowp = O + (size_t)(row0 + ai * 128 + mp * 32) * DM + col0;
#pragma unroll
                for (int bj = 0; bj < 2; ++bj) { u32x2 w[2];
#pragma unroll
                    for (int mm = 0; mm < 2; ++mm) { const int m = 2 * mp + mm; const f32x4 v0 = acc[ai][bj][m][0] * scale, v1 = acc[ai][bj][m][1] * scale;
                        w[mm].x = pk4_fp8(v0[0], v0[1], v0[2], v0[3]); w[mm].y = pk4_fp8(v1[0], v1[1], v1[2], v1[3]); }
                    *(u32x4*)(rowp + bj * 128) = pair16(w[0], w[1]); }
                asm volatile("" ::: "memory"); }
    }
};

constexpr int XL_OFF = 192;
constexpr int CW_CT = 1024, CW_TMO2 = 960;
template <int MODE> struct MoeOrderT {
    static constexpr int A_AUX = MODE == 1 ? 16 : 0; static constexpr bool HANDOFF = true;
    const LAS int* tab; const int* tok; const unsigned* cnt; unsigned* ctl; int G, c, rb, gather; size_t bstride;
    __device__ __forceinline__ bool next(int i, pg8::Unit& u) const {
        if (i >= 32) return false;
        const int ent = tab[XL_OFF + 32 * MODE + i]; if (ent < 0) return false;
        const int t = ent >> 2, info = tab[1 + t]; u.pm = t; u.pn = ent & 3; u.e = info & 255; u.r0 = info >> 8; return true;
    }
    __device__ __forceinline__ unsigned a_off(const pg8::Unit& u, int r) const {
        if (MODE == 0) { const int n = (int)cnt[u.e]; int idx = u.r0 + r; idx = idx < n ? idx : n - 1; const int t = tok[u.e * CAP + idx]; return (unsigned)t * (unsigned)rb; }
        return (unsigned)(u.pm * 256 + r) * (unsigned)rb;
    }
    __device__ __forceinline__ size_t b_off(const pg8::Unit& u) const { return (size_t)u.e * bstride + (size_t)u.pn * 256 * rb; }
    __device__ __forceinline__ void publish(int pm) const {
        if (MODE == 0) { if ((threadIdx.x & 63) == 0) __hip_atomic_fetch_add(ctl + CW_CT + 16 * pm, 1u, __ATOMIC_RELAXED, __HIP_MEMORY_SCOPE_AGENT); }
    }
    __device__ __forceinline__ unsigned poll_begin(const pg8::Unit& u) const {
        if (MODE == 1) return __hip_atomic_load(ctl + CW_CT + 16 * u.pm, __ATOMIC_RELAXED, __HIP_MEMORY_SCOPE_AGENT);
        return 0u;
    }
    __device__ __forceinline__ void poll_end(const pg8::Unit& u, unsigned v) const {
        if (MODE == 1) { unsigned sp = 0u; v = (unsigned)__builtin_amdgcn_readfirstlane((int)v);
            while (v < 32u) {
                __builtin_amdgcn_s_sleep(2);
                if ((++sp & 255u) == 0u) { if (__hip_atomic_load(ctl + CW_TMO2, __ATOMIC_RELAXED, __HIP_MEMORY_SCOPE_AGENT) != 0u) break;
                    if (sp > (1u << 20)) { __hip_atomic_store(ctl + CW_TMO2, 1u, __ATOMIC_RELAXED, __HIP_MEMORY_SCOPE_AGENT); break; } }
                v = (unsigned)__builtin_amdgcn_readfirstlane((int)__hip_atomic_load(ctl + CW_CT + 16 * u.pm, __ATOMIC_RELAXED, __HIP_MEMORY_SCOPE_AGENT)); }
            asm volatile("" ::: "memory"); }
    }
};
__device__ __forceinline__ void build_moe_table(LAS int* tab, const unsigned* cnt, int tid) {
    if (tid < 64) { const int e = tid; const int n = e < NEXP ? (int)cnt[e] : 0; const int tiles = (n + 255) >> 8; int incl = tiles;
#pragma unroll
        for (int o = 1; o < 32; o <<= 1) { const int v = __shfl_up(incl, o); if (tid >= o) incl += v; }
        const int first = incl - tiles;
        if (e < NEXP) for (int k = 0; k < tiles; ++k) tab[1 + first + k] = e | ((k * 256) << 8);
        { const int x = (int)blockIdx.x & 7, G = (int)gridDim.x, W = (G - x + 7) >> 3, r = (int)blockIdx.x >> 3, mode = tid >> 5, i = tid & 31;
          const int f0 = __shfl(first, x), f1 = __shfl(first, x + 8), f2 = __shfl(first, x + 16), f3 = __shfl(first, x + 24);
          const int n0 = __shfl(tiles, x), n1 = __shfl(tiles, x + 8), n2 = __shfl(tiles, x + 16), n3 = __shfl(tiles, x + 24), nx = 4 * (n0 + n1 + n2 + n3);
          int j = nx;
          if (mode == 0) j = i * W + r;
          else if (nx > 0) {
              const int K = (nx + W - 1) / W, R = nx - (K - 1) * W, nL = R, nS = W - R; const bool mineS = r >= R; const int myidx = mineS ? r - R : r;
              int tL = 3 * K, tS = 3 * (K - 1), done = 0, turn = 0;
              while (done < nx) { const bool pickS = nS > 0 && tS <= tL; const int avail = pickS ? nS : nL, left = nx - done, m = avail < left ? avail : left;
                  if (pickS == mineS) { if (turn == i && myidx < m) j = done + myidx; ++turn; }
                  if (pickS) tS += 2; else tL += 2;
                  done += m; } }
          int ent = -1;
          if (j < nx) { int q = j >> 2, t;
              if (q < n0) t = f0 + q; else { q -= n0; if (q < n1) t = f1 + q; else { q -= n1; if (q < n2) t = f2 + q; else t = f3 + q - n2; } }
              ent = (t << 2) | (j & 3); }
          tab[XL_OFF + tid] = ent; }
        if (e == NEXP - 1) tab[0] = incl; }
}

typedef GAS unsigned gu32;
#define RLX_AGENT __ATOMIC_RELAXED, __HIP_MEMORY_SCOPE_AGENT
#define XB_TMO      128
#define XB_XCNT(j)  (256  + 64 * (j))
#define XB_XSUB(j)  (1280 + 64 * (j))
#define XB_XGEN(j)  (2304 + 64 * (j))
#define XB_TOP      3328
#define XB_TOPGEN   3392
#define XCD_BAR_WORDS 3456
#define XB_SPIN_CAP (1u << 18)
constexpr int CW_BAR_TMO = 4096 + XB_TMO;
__device__ __forceinline__ unsigned xb_ld(unsigned* p)              { return __hip_atomic_load(p, __ATOMIC_RELAXED, __HIP_MEMORY_SCOPE_AGENT); }
__device__ __forceinline__ unsigned xb_add(unsigned* p, unsigned v) { return __hip_atomic_fetch_add(p, v, __ATOMIC_RELAXED, __HIP_MEMORY_SCOPE_AGENT); }
__device__ __forceinline__ unsigned xb_xcc_id() { return (unsigned)__builtin_amdgcn_s_getreg((3 << 11) | 20) & 0xFu; }
#define XB_SPIN(cond, bar) do { unsigned _sp = 0; while (cond) { __builtin_amdgcn_s_sleep(1); \
    if ((++_sp & 255u) == 0u) { if (xb_ld(&(bar)[XB_TMO])) break; if (_sp > XB_SPIN_CAP) { atomicAdd(&(bar)[XB_TMO], 1u); break; } } } } while (0)
struct XcdBarrier { unsigned* bar; unsigned x; volatile LAS unsigned* st; };
__device__ __forceinline__ XcdBarrier xcd_barrier_post(unsigned* bar, volatile LAS unsigned* st) {
    XcdBarrier b; b.bar = bar; b.x = xb_xcc_id(); b.st = st;
    if (threadIdx.x == 0) (void)xb_add(&bar[XB_XCNT(b.x)], 1u);
    return b;
}
__device__ __forceinline__ void xcd_barrier_complete(unsigned* bar, unsigned x, unsigned& nloc, unsigned& nx) {
    const unsigned G = gridDim.x * gridDim.y * gridDim.z;
    unsigned sum, cnt, mine, sp = 0u;
    for (;;) {
        sum = 0u; cnt = 0u; mine = 0u;
#pragma unroll
        for (unsigned j = 0; j < 16; ++j) { const unsigned c = xb_ld(&bar[XB_XCNT(j)]); sum += c; cnt += (c > 0u) ? 1u : 0u; mine = (j == x) ? c : mine; }
        if (sum == G) break;
        __builtin_amdgcn_s_sleep(1);
        if ((++sp & 255u) == 0u) { if (xb_ld(&bar[XB_TMO])) break; if (sp > XB_SPIN_CAP) { atomicAdd(&bar[XB_TMO], 1u); break; } }
    }
    nloc = mine > 0u ? mine : 1u; nx = cnt > 0u ? cnt : 1u;
}
__device__ __forceinline__ void xcd_barrier(const XcdBarrier& b) {
    asm volatile("s_waitcnt vmcnt(0)" ::: "memory");
    __syncthreads();
    if (threadIdx.x == 0) {
        unsigned* bar = b.bar;
        __builtin_amdgcn_s_waitcnt(0);
        unsigned nloc = b.st[0], nx = b.st[1];
        if (nloc == 0u) { xcd_barrier_complete(bar, b.x, nloc, nx); b.st[0] = nloc; b.st[1] = nx; }
        const unsigned old = xb_add(&bar[XB_XSUB(b.x)], 1u);
        const unsigned gen = old / nloc;
        if (old + 1u == (gen + 1u) * nloc) {
            __builtin_amdgcn_fence(__ATOMIC_RELEASE, "agent");
            asm volatile("s_waitcnt vmcnt(0)" ::: "memory");
            const unsigned og = xb_add(&bar[XB_TOP], 1u);
            const unsigned tg = og / nx;
            if (og + 1u == (tg + 1u) * nx) xb_add(&bar[XB_TOPGEN], 1u);
            else XB_SPIN(xb_ld(&bar[XB_TOPGEN]) == tg, bar);
            __builtin_amdgcn_fence(__ATOMIC_ACQUIRE, "agent");
            xb_add(&bar[XB_XGEN(b.x)], 1u);
            asm volatile("s_waitcnt vmcnt(0)" ::: "memory");
        } else {
            XB_SPIN(xb_ld(&bar[XB_XGEN(b.x)]) == gen, bar);
            __builtin_amdgcn_fence(__ATOMIC_ACQUIRE, "agent");
            asm volatile("s_waitcnt vmcnt(0)" ::: "memory");
        }
    }
    __syncthreads();
}

constexpr int CW_TEAM = 128;
__device__ __forceinline__ void team_barrier(unsigned* ctl, unsigned target) {
    asm volatile("s_waitcnt vmcnt(0)" ::: "memory");
    __syncthreads();
    if (threadIdx.x == 0) {
        unsigned* w = ctl + CW_TEAM + 8 * (((int)blockIdx.x & 7) * 8 + (((int)blockIdx.x >> 3) & 7));
        (void)xb_add(w, 1u);
        unsigned sp = 0u;
        while (xb_ld(w) < target) { __builtin_amdgcn_s_sleep(1);
            if ((++sp & 255u) == 0u) { if (xb_ld(ctl + CW_BAR_TMO)) break; if (sp > XB_SPIN_CAP) { atomicAdd(ctl + CW_BAR_TMO, 1u); break; } } }
        __builtin_amdgcn_fence(__ATOMIC_ACQUIRE, "agent");
        asm volatile("s_waitcnt vmcnt(0)" ::: "memory");
    }
    __syncthreads();
}

#ifndef REPEAT_PHASE
#define REPEAT_PHASE -1
#endif
struct P { const float* in[20]; float* out; unsigned char* ws; int ph_lo, ph_hi; };
constexpr int CW_BAR = 4096;
constexpr int MISC_OFF = 131072 + 320;

__device__ __forceinline__ void transpose_item(const float* W, int ldw, bf16* WT, int K, int drow0, int k0, int n0, LAS float* scr, int lane, float sc = 1.0f) {
#pragma unroll 8
    for (int i = 0; i < 32; ++i) { const int kk = 2 * i + (lane >> 5); scr[kk * 33 + (lane & 31)] = W[(size_t)(k0 + kk) * ldw + n0 + (lane & 31)]; }
    asm volatile("s_waitcnt lgkmcnt(0)" ::: "memory");
    const int c = lane & 7;
#pragma unroll
    for (int j = 0; j < 4; ++j) { const int n = (lane >> 3) + 8 * j; const LAS float* s = scr + (8 * c) * 33 + n;
        u32x4 o; o.x = cvt_pk_bf16(s[0 * 33] * sc, s[1 * 33] * sc); o.y = cvt_pk_bf16(s[2 * 33] * sc, s[3 * 33] * sc); o.z = cvt_pk_bf16(s[4 * 33] * sc, s[5 * 33] * sc); o.w = cvt_pk_bf16(s[6 * 33] * sc, s[7 * 33] * sc);
        *(u32x4*)(WT + (size_t)(drow0 + n) * K + k0 + 8 * c) = o; }
    asm volatile("s_waitcnt lgkmcnt(0)" ::: "memory");
}
struct TItem { const float* W; unsigned char* WT; int K, drow0, k0, n0; };
__device__ __forceinline__ void moe_item(const P& p, int it, TItem& t) {
    unsigned char* ws = p.ws;
    if (it < 32 * 512) { const int e = it >> 9, q = it & 511, kb = q >> 5, nb = q & 31, n0 = 32 * nb, j = n0 & 511, isu = n0 >> 9;
        t.W = p.in[17] + (size_t)e * 1024 * 1024; t.WT = ws + WS_WGU + (size_t)e * 1024 * 1024; t.K = 1024; t.drow0 = 256 * (j >> 7) + 128 * isu + (j & 127); t.k0 = 64 * kb; t.n0 = n0; }
    else { const int r = it - 32 * 512, e = r >> 8, q = r & 255, kb = q >> 5, nb = q & 31;
        t.W = p.in[18] + (size_t)e * 512 * 1024; t.WT = ws + WS_WD + (size_t)e * 1024 * 512; t.K = 512; t.drow0 = 32 * nb; t.k0 = 64 * kb; t.n0 = 32 * nb; }
}
constexpr int N_MOE_ITEMS = 32 * 512 + 32 * 256;
#ifndef MOE_ITEMS_A
#define MOE_ITEMS_A 13312
#endif
#ifndef MOE_ITEMS_B
#define MOE_ITEMS_B 18432
#endif
__device__ __forceinline__ void moe_item_load(const TItem& t, f32x4 (&r)[8], int lane) {
    const float* src = t.W + (size_t)(t.k0 + (lane >> 3)) * 1024 + t.n0 + (lane & 7) * 4;
#pragma unroll
    for (int i = 0; i < 8; ++i) r[i] = __builtin_nontemporal_load((const f32x4*)(src + (size_t)i * 8 * 1024));
}
__device__ __forceinline__ void moe_item_store(const TItem& t, const f32x4 (&r)[8], LAS float* scr, int lane) {
#pragma unroll
    for (int i = 0; i < 8; ++i) { LAS float* d = scr + ((lane >> 3) + 8 * i) * 33 + (lane & 7) * 4; d[0] = r[i].x; d[1] = r[i].y; d[2] = r[i].z; d[3] = r[i].w; }
    asm volatile("s_waitcnt lgkmcnt(0)" ::: "memory");
    const int c = lane & 7;
#pragma unroll
    for (int j = 0; j < 4; ++j) { const int n = (lane >> 3) + 8 * j; const LAS float* s = scr + (8 * c) * 33 + n;
        u32x2 o; o.x = pk4_fp8(s[0 * 33] * WSCALE, s[1 * 33] * WSCALE, s[2 * 33] * WSCALE, s[3 * 33] * WSCALE); o.y = pk4_fp8(s[4 * 33] * WSCALE, s[5 * 33] * WSCALE, s[6 * 33] * WSCALE, s[7 * 33] * WSCALE);
        __builtin_nontemporal_store(o, (u32x2*)(t.WT + (size_t)(t.drow0 + n) * t.K + t.k0 + 8 * c)); }
    asm volatile("s_waitcnt lgkmcnt(0)" ::: "memory");
}
__device__ __forceinline__ void ph_moe_convert(const P& p, LAS unsigned char* lds, int first, int last, int wv, int nwv, int wave, int lane) {
    LAS float* scr = (LAS float*)(lds + wave * 16384);
    TItem t[4]; f32x4 r[4][8]; int idx[4];
    const int N_MOE_ITEMS = last;
#pragma unroll
    for (int j = 0; j < 4; ++j) { idx[j] = first + wv + j * nwv; t[j].W = nullptr; t[j].WT = nullptr; t[j].K = 0; t[j].drow0 = 0; t[j].k0 = 0; t[j].n0 = 0; if (idx[j] < N_MOE_ITEMS) { moe_item(p, idx[j], t[j]); moe_item_load(t[j], r[j], lane); } }
    for (;;) {
        if (idx[0] >= N_MOE_ITEMS) break;
#pragma unroll
        for (int j = 0; j < 4; ++j) { if (idx[j] < N_MOE_ITEMS) { moe_item_store(t[j], r[j], scr, lane); idx[j] += 4 * nwv; if (idx[j] < N_MOE_ITEMS) { moe_item(p, idx[j], t[j]); moe_item_load(t[j], r[j], lane); } } }
    }
}
__device__ __forceinline__ void rms_rows4_to_bf16(const float* x, const float* gain, bf16* o, int row0, int lane) {
    f32x4 v[4][4]; float s[4];
#pragma unroll
    for (int q = 0; q < 4; ++q) { const f32x4* xr = (const f32x4*)(x + (size_t)(row0 + q) * DM) + lane;
#pragma unroll
        for (int j = 0; j < 4; ++j) v[q][j] = xr[64 * j]; }
#pragma unroll
    for (int q = 0; q < 4; ++q) { s[q] = 0.f;
#pragma unroll
        for (int j = 0; j < 4; ++j) s[q] += (v[q][j].x * v[q][j].x + v[q][j].y * v[q][j].y) + (v[q][j].z * v[q][j].z + v[q][j].w * v[q][j].w); }
#pragma unroll
    for (int o_ = 1; o_ < 64; o_ <<= 1) { s[0] += __shfl_xor(s[0], o_); s[1] += __shfl_xor(s[1], o_); s[2] += __shfl_xor(s[2], o_); s[3] += __shfl_xor(s[3], o_); }
    const f32x4* gr = (const f32x4*)gain + lane;
#pragma unroll
    for (int q = 0; q < 4; ++q) { const float rinv = 1.0f / sqrtf(s[q] * (1.f / DM) + EPS); u32x2* o8 = (u32x2*)(o + (size_t)(row0 + q) * DM) + lane;
#pragma unroll
        for (int j = 0; j < 4; ++j) { const f32x4 g = gr[64 * j]; u32x2 w; w.x = cvt_pk_bf16(v[q][j].x * rinv * g.x, v[q][j].y * rinv * g.y); w.y = cvt_pk_bf16(v[q][j].z * rinv * g.z, v[q][j].w * rinv * g.w); o8[64 * j] = w; } }
}
__device__ __forceinline__ void ph_prologue(const P& p, LAS unsigned char* lds, int gw, int NGW, int wave, int lane) {
    LAS float* scr = (LAS float*)(lds + wave * 16384);
    unsigned char* ws = p.ws;
    constexpr int I_IN = 16 * 200, I_PA = 4 * 32, I_PL = 16 * 32, I_OUT = 16 * 32;
    constexpr int NITEMS = I_IN + I_PA + I_PL + I_OUT;
    for (int it = gw; it < NITEMS; it += NGW) {
        int r = it;
        if (r < I_IN) { const int kb = r / 200, nb = r % 200; transpose_item(p.in[3], INW, (bf16*)(ws + WS_WIN), 1024, 32 * nb, 64 * kb, 32 * nb, scr, lane, 32 * nb < C_K ? 0.125f : (32 * nb >= C_GM ? -1.4426950408889634f : 1.0f)); continue; }     r -= I_IN;
        if (r < I_PA) { const int kb = r / 32, nb = r % 32; transpose_item(p.in[11], 1024, (bf16*)(ws + WS_WPLA) + 1024, CAW, 32 * nb, 64 * kb, 32 * nb, scr, lane); continue; } r -= I_PA;
        if (r < I_PL) { const int kb = r / 32, nb = r % 32; transpose_item(p.in[12], 1024, (bf16*)(ws + WS_WPLA), CAW, 32 * nb, 64 * kb, 32 * nb, scr, lane); continue; } r -= I_PL;
        { const int kb = r / 32, nb = r % 32; transpose_item(p.in[13], 1024, (bf16*)(ws + WS_WOUT), 1024, 32 * nb, 64 * kb, 32 * nb, scr, lane); }
    }
    for (int m = gw * 4; m < M; m += NGW * 4) rms_rows4_to_bf16(p.in[0], p.in[2], (bf16*)(ws + WS_H), m, lane);
    {
        bf16* WRT = (bf16*)(ws + WS_WRT); const float* g2 = p.in[14]; const float* wg = p.in[15]; const float* we = p.in[16];
        for (int e = gw * 64 + lane; e < 48 * 1024; e += NGW * 64) { const int c = e >> 10, k = e & 1023; float v = 0.f;
            if (c < 4) v = wg[k * 4 + c] * g2[k]; else if (c < 36) v = we[k * 32 + (c - 4)] * g2[k];
            const unsigned short hi = f2bf(v); const unsigned short lo = f2bf(v - bf2f(hi)); const int kb = k >> 5, kk = k & 31;
            WRT[((kb * 2 + 0) * 48 + c) * 32 + kk] = hi; WRT[((kb * 2 + 1) * 48 + c) * 32 + kk] = lo; } }
}

typedef short v4i16_t __attribute__((ext_vector_type(4)));
constexpr int AT_KS = 0, AT_KP = 144, AT_VS = 36864, AT_VP = 160, AT_RT = 77824;
constexpr int N_ATT_UNITS = 2 * 3 * 64 * 4;
struct AttStage { u32x4 k[4], v[4]; bf16x8 q[2]; };
__device__ __forceinline__ void att_decode(int U, int& b, int& g, int& h, int& d, int& r, int& nblk) {
    const int hh = U & 3, combo = (U >> 2) & 63, bg = U >> 8; b = bg / 3; g = bg - 3 * b; h = 4 * g + hh; const int dsh = 2 * g; d = 1 << dsh; r = combo >> (6 - dsh); nblk = combo & ((64 >> dsh) - 1);
}
__device__ __forceinline__ void att_load(AttStage& st, const bf16* __restrict__ PROJ, int U, int tid, int w, int fr, int fq) {
    int b, g, h, d, r, nblk; att_decode(U, b, g, h, d, r, nblk);
#pragma unroll
    for (int i = 0; i < 4; ++i) { const int pid = tid + 512 * i, key = pid >> 3, ch = pid & 7; int kpos = 128 * (nblk - 1) + key; kpos = kpos < 0 ? 0 : kpos;
        const bf16* rp = PROJ + (size_t)(b * SEQ + kpos * d + r) * INW + h * 64 + ch * 8;
        st.k[i] = *(const u32x4*)(rp + C_K); st.v[i] = *(const u32x4*)(rp + C_V); }
    const bf16* qp = PROJ + (size_t)(b * SEQ + (128 * nblk + 16 * w + fr) * d + r) * INW + h * 64 + 8 * fq;
    st.q[0] = *(const bf16x8*)qp; st.q[1] = *(const bf16x8*)(qp + 32);
}
__device__ __forceinline__ void ph_attention(const bf16* __restrict__ PROJ, const float* __restrict__ rel_bias, bf16* __restrict__ OG, float* __restrict__ LSE, LAS unsigned char* lds, int c, int G, int tid) {
    const int lane = tid & 63, w = __builtin_amdgcn_readfirstlane(tid >> 6), fr = lane & 15, fq = lane >> 4;
    LAS unsigned char* KS = lds + AT_KS; LAS unsigned char* VS = lds + AT_VS; LAS float* RTB = (LAS float*)(lds + AT_RT);
    int U = c; if (U >= N_ATT_UNITS) return;
    lds_barrier();
    for (int e = tid; e < 12 * 160; e += 512) { const int hd = e / 160, x = e - hd * 160, u = x + 112; RTB[e] = (u >= 128 && u <= 256) ? rel_bias[(int)BUCKET[hd >> 2][256 - u] * 12 + hd] : -1e30f; }
    AttStage st; att_load(st, PROJ, U, tid, w, fr, fq);
    for (; U < N_ATT_UNITS; U += G) {
        int b, g, h, d, r, nblk; att_decode(U, b, g, h, d, r, nblk);
        __syncthreads();
#pragma unroll
        for (int i = 0; i < 4; ++i) { const int pid = tid + 512 * i, key = pid >> 3, ch = pid & 7;
            *(LAS u32x4*)(KS + key * AT_KP + ch * 16) = st.k[i]; *(LAS u32x4*)(VS + key * AT_VP + ch * 16) = st.v[i]; }
        const bf16x8 q0 = st.q[0], q1 = st.q[1]; const LAS float* RT = RTB + h * 160;
        __syncthreads();
        if (U + G < N_ATT_UNITS) att_load(st, PROJ, U + G, tid, w, fr, fq);
        f32x4 sc[9];
#pragma unroll
        for (int tt = 0; tt < 9; ++tt) { const LAS unsigned char* kp = KS + (16 * (w + tt) + fr) * AT_KP + fq * 16;
            f32x4 acc = (f32x4){0.f, 0.f, 0.f, 0.f};
            acc = __builtin_amdgcn_mfma_f32_16x16x32_bf16(*(const LAS bf16x8*)kp, q0, acc, 0, 0, 0);
            acc = __builtin_amdgcn_mfma_f32_16x16x32_bf16(*(const LAS bf16x8*)(kp + 64), q1, acc, 0, 0, 0);
            sc[tt] = acc; }
        float mx = -3.0e38f;
#pragma unroll
        for (int tt = 0; tt < 9; ++tt)
#pragma unroll
            for (int i = 0; i < 4; ++i) { float v = sc[tt][i] + RT[16 * tt + 4 * fq + i - fr + 16];
                if (nblk == 0 && (w + tt) < 8) v = -1e30f;
                sc[tt][i] = v; mx = fmaxf(mx, v); }
        mx = fmaxf(mx, __shfl_xor(mx, 16)); mx = fmaxf(mx, __shfl_xor(mx, 32));
        float ls = 0.f;
#pragma unroll
        for (int tt = 0; tt < 9; ++tt)
#pragma unroll
            for (int i = 0; i < 4; ++i) { const float pv = __builtin_amdgcn_exp2f((sc[tt][i] - mx) * 1.4426950408889634f); sc[tt][i] = pv; ls += pv; }
        f32x4 od[4];
#pragma unroll
        for (int dt = 0; dt < 4; ++dt) od[dt] = (f32x4){0.f, 0.f, 0.f, 0.f};
        const int vq = (lane & 15) >> 2, vp = lane & 3;
#pragma unroll
        for (int kb = 0; kb < 5; ++kb) { const int T0 = w + 2 * kb, T1 = kb < 4 ? T0 + 1 : T0;
            u32x4 pk; pk.x = cvt_pk_bf16(sc[2 * kb][0], sc[2 * kb][1]); pk.y = cvt_pk_bf16(sc[2 * kb][2], sc[2 * kb][3]);
            if (kb < 4) { pk.z = cvt_pk_bf16(sc[2 * kb + 1][0], sc[2 * kb + 1][1]); pk.w = cvt_pk_bf16(sc[2 * kb + 1][2], sc[2 * kb + 1][3]); } else { pk.z = 0u; pk.w = 0u; }
            const bf16x8 pb = __builtin_bit_cast(bf16x8, pk);
            const LAS unsigned char* v0 = VS + (16 * T0 + 4 * fq + vq) * AT_VP + 8 * vp; const LAS unsigned char* v1 = VS + (16 * T1 + 4 * fq + vq) * AT_VP + 8 * vp;
#pragma unroll
            for (int dt = 0; dt < 4; ++dt) {
                const v4i16_t a0 = __builtin_amdgcn_ds_read_tr16_b64_v4i16((LAS v4i16_t*)(v0 + dt * 32)), a1 = __builtin_amdgcn_ds_read_tr16_b64_v4i16((LAS v4i16_t*)(v1 + dt * 32));
                bf16x8 va; va[0] = a0[0]; va[1] = a0[1]; va[2] = a0[2]; va[3] = a0[3]; va[4] = a1[0]; va[5] = a1[1]; va[6] = a1[2]; va[7] = a1[3];
                od[dt] = __builtin_amdgcn_mfma_f32_16x16x32_bf16(va, pb, od[dt], 0, 0, 0); } }
        ls += __shfl_xor(ls, 16); ls += __shfl_xor(ls, 32);
        const float inv = 1.0f / ls;
        const size_t orow = (size_t)g * M + (size_t)(b * SEQ + (128 * nblk + 16 * w + fr) * d + r);
        bf16* op = OG + orow * 256 + (h & 3) * 64 + 4 * fq;
#pragma unroll
        for (int dt = 0; dt < 4; ++dt) { u32x2 o; o.x = cvt_pk_bf16(od[dt][0] * inv, od[dt][1] * inv); o.y = cvt_pk_bf16(od[dt][2] * inv, od[dt][3] * inv); *(u32x2*)(op + 16 * dt) = o; }
        if (fq == 0) LSE[(size_t)U * 128 + 16 * w + fr] = mx + __logf(ls);
    }
}

constexpr int LR_WT = 0, LR_XCB = 18432, LR_BF = 36864, LR_AF = 71680, LR_AG = 106496, LR_P = 144, LR_FP = 68;
constexpr int N_LRU_UNITS = 2 * 64 * 16;
struct LruX { u32x4 x[2][4]; };
__device__ __forceinline__ void lru_load_x(LruX& X, const bf16* __restrict__ PROJ, int U, int tid) {
    const int h = U & 15, idx = U >> 4, b = idx >> 6, ck = idx & 63, t0 = ck * 128; const size_t row0 = (size_t)b * SEQ + t0;
#pragma unroll
    for (int it = 0; it < 2; ++it) { const int item = tid + 512 * it, tok = item >> 3, cg = item & 7, c0 = 64 * h + 8 * cg;
#pragma unroll
        for (int j = 0; j < 4; ++j) { const int tt = t0 + tok - 3 + j; u32x4 v = (u32x4){0u, 0u, 0u, 0u};
            if (tt >= 0) v = *(const u32x4*)(PROJ + (row0 + tok - 3 + j) * INW + C_XR + c0);
            X.x[it][j] = v; } }
}
__device__ __forceinline__ void ph_lru_local(const bf16* __restrict__ PROJ, const P& p, bf16* __restrict__ HL, bf16* __restrict__ PC, float* __restrict__ AGG, LAS unsigned char* lds, int c, int G, int tid) {
    const float* conv_w = p.in[4]; const float* conv_b = p.in[5]; const float* w_rg = p.in[6]; const float* b_rg = p.in[7]; const float* w_ig = p.in[8]; const float* b_ig = p.in[9]; const float* lam = p.in[10];
    const int lane = tid & 63, w = __builtin_amdgcn_readfirstlane(tid >> 6), fr = lane & 15, fq = lane >> 4;
    LAS unsigned char* WT = lds + LR_WT; LAS unsigned char* XCB = lds + LR_XCB; LAS float* BFl = (LAS float*)(lds + LR_BF); LAS float* AFl = (LAS float*)(lds + LR_AF); LAS float* AG = (LAS float*)(lds + LR_AG);
    int U = c; if (U >= N_LRU_UNITS) return;
    int cur_h = -1;
    float cw[4][8], cb[8], brg[4], big[4], cc[4];
    LruX X; lru_load_x(X, PROJ, U, tid);
    for (; U < N_LRU_UNITS; U += G) {
        const int h = U & 15, idx = U >> 4, b = idx >> 6, ck = idx & 63, t0 = ck * 128; const size_t row0 = (size_t)b * SEQ + t0;
        __syncthreads();
        if (h != cur_h) { cur_h = h;
            for (int e = tid; e < 2 * 64 * 16; e += 512) { const int gate = e >> 10, rem = e & 1023, iin = rem >> 4, j4 = (rem & 15) * 4;
                const f32x4 wv = *(const f32x4*)((gate ? w_ig : w_rg) + (size_t)(h * 64 + iin) * 64 + j4);
                LAS unsigned short* dst = (LAS unsigned short*)(WT + (gate * 64 + j4) * LR_P + iin * 2);
                dst[0] = f2bf(wv.x); dst[LR_P / 2] = f2bf(wv.y); dst[LR_P] = f2bf(wv.z); dst[3 * LR_P / 2] = f2bf(wv.w); }
            { const int c0 = 64 * h + 8 * (tid & 7);
                const f32x4 b0 = *(const f32x4*)(conv_b + c0), b1 = *(const f32x4*)(conv_b + c0 + 4); cb[0] = b0.x; cb[1] = b0.y; cb[2] = b0.z; cb[3] = b0.w; cb[4] = b1.x; cb[5] = b1.y; cb[6] = b1.z; cb[7] = b1.w;
#pragma unroll
                for (int j = 0; j < 4; ++j) { const f32x4 w0 = *(const f32x4*)(conv_w + j * 1024 + c0), w1 = *(const f32x4*)(conv_w + j * 1024 + c0 + 4);
                    cw[j][0] = w0.x; cw[j][1] = w0.y; cw[j][2] = w0.z; cw[j][3] = w0.w; cw[j][4] = w1.x; cw[j][5] = w1.y; cw[j][6] = w1.z; cw[j][7] = w1.w; } }
#pragma unroll
            for (int jt = 0; jt < 4; ++jt) { const int c = 64 * h + 16 * jt + fr; brg[jt] = -1.4426950408889634f * b_rg[c]; big[jt] = -1.4426950408889634f * b_ig[c]; const float nl = -lam[c]; cc[jt] = 8.0f * (nl > 20.f ? nl : log1pf(expf(nl))); } }
#pragma unroll
        for (int it = 0; it < 2; ++it) { const int item = tid + 512 * it, tok = item >> 3, cg = item & 7;
            float xc[8];
#pragma unroll
            for (int q = 0; q < 8; ++q) xc[q] = cb[q];
#pragma unroll
            for (int j = 0; j < 4; ++j) { const u32x4 xv = X.x[it][j];
                xc[0] += cw[j][0] * bflo(xv.x); xc[1] += cw[j][1] * bfhi(xv.x); xc[2] += cw[j][2] * bflo(xv.y); xc[3] += cw[j][3] * bfhi(xv.y);
                xc[4] += cw[j][4] * bflo(xv.z); xc[5] += cw[j][5] * bfhi(xv.z); xc[6] += cw[j][6] * bflo(xv.w); xc[7] += cw[j][7] * bfhi(xv.w); }
            u32x4 pk; pk.x = cvt_pk_bf16(xc[0], xc[1]); pk.y = cvt_pk_bf16(xc[2], xc[3]); pk.z = cvt_pk_bf16(xc[4], xc[5]); pk.w = cvt_pk_bf16(xc[6], xc[7]);
            *(LAS u32x4*)(XCB + tok * LR_P + cg * 16) = pk;
            *(LAS f32x4*)(BFl + tok * LR_FP + cg * 8) = (f32x4){xc[0], xc[1], xc[2], xc[3]}; *(LAS f32x4*)(BFl + tok * LR_FP + cg * 8 + 4) = (f32x4){xc[4], xc[5], xc[6], xc[7]}; }
        __syncthreads();
        if (U + G < N_LRU_UNITS) lru_load_x(X, PROJ, U + G, tid);
        const bf16x8 a0 = *(const LAS bf16x8*)(XCB + (16 * w + fr) * LR_P + fq * 16), a1 = *(const LAS bf16x8*)(XCB + (16 * w + fr) * LR_P + 64 + fq * 16);
#pragma unroll
        for (int jt = 0; jt < 4; ++jt) {
            f32x4 ra = (f32x4){0.f, 0.f, 0.f, 0.f}, ia = (f32x4){0.f, 0.f, 0.f, 0.f};
            const LAS unsigned char* wrp = WT + (16 * jt + fr) * LR_P + fq * 16; const LAS unsigned char* wip = wrp + 64 * LR_P;
            ra = __builtin_amdgcn_mfma_f32_16x16x32_bf16(a0, *(const LAS bf16x8*)wrp, ra, 0, 0, 0); ra = __builtin_amdgcn_mfma_f32_16x16x32_bf16(a1, *(const LAS bf16x8*)(wrp + 64), ra, 0, 0, 0);
            ia = __builtin_amdgcn_mfma_f32_16x16x32_bf16(a0, *(const LAS bf16x8*)wip, ia, 0, 0, 0); ia = __builtin_amdgcn_mfma_f32_16x16x32_bf16(a1, *(const LAS bf16x8*)(wip + 64), ia, 0, 0, 0);
            const int ch = 16 * jt + fr;
#pragma unroll
            for (int i = 0; i < 4; ++i) { const int tok = 16 * w + 4 * fq + i;
                const float rg = __builtin_amdgcn_rcpf(1.0f + __builtin_amdgcn_exp2f(__builtin_fmaf(ra[i], -1.4426950408889634f, brg[jt])));
                const float ig = __builtin_amdgcn_rcpf(1.0f + __builtin_amdgcn_exp2f(__builtin_fmaf(ia[i], -1.4426950408889634f, big[jt])));
                const float x = -cc[jt] * rg, av = __builtin_amdgcn_exp2f(x * 1.4426950408889634f), x2 = x + x;
                const float om = x2 > -0.02f ? -x2 * (1.0f + x2 * (0.5f + x2 * (1.0f / 6.0f))) : 1.0f - av * av;
                const float xcv = BFl[tok * LR_FP + ch];
                AFl[tok * LR_FP + ch] = av; BFl[tok * LR_FP + ch] = __builtin_amdgcn_sqrtf(om) * (ig * xcv); } }
        __syncthreads();
        float Ps[16], hs[16]; { float Pr = 1.f, hr = 0.f;
#pragma unroll
            for (int t = 0; t < 16; ++t) { const float av = AFl[(16 * w + t) * LR_FP + lane], bv = BFl[(16 * w + t) * LR_FP + lane]; Pr *= av; hr = av * hr + bv; Ps[t] = Pr; hs[t] = hr; }
            AG[w * 128 + lane] = Pr; AG[w * 128 + 64 + lane] = hr; }
        __syncthreads();
        float Ain = 1.f, Hin = 0.f;
        for (int k = 0; k < w; ++k) { const float ak = AG[k * 128 + lane], hk = AG[k * 128 + 64 + lane]; Hin = ak * Hin + hk; Ain *= ak; }
        bf16* hlp = HL + (row0 + 16 * w) * DM + 64 * h + lane; unsigned char* pcp = (unsigned char*)PC + (row0 + 16 * w) * DM + 64 * h + lane;
#pragma unroll
        for (int t = 0; t < 16; ++t) { hlp[(size_t)t * DM] = f2bf(hs[t] + Ps[t] * Hin); pcp[(size_t)t * DM] = (unsigned char)__builtin_amdgcn_cvt_pk_u8_f32(__builtin_rintf(Ps[t] * Ain * 255.f), 0, 0u); }
        if (w == 7) { float* ag = AGG + ((size_t)(b * 64 + ck) * 2) * 1024 + 64 * h + lane; ag[0] = Ps[15] * Ain; ag[1024] = hs[15] + Ps[15] * Hin; }
    }
}

__device__ __forceinline__ void ph_fixup(const bf16* __restrict__ HL, const bf16* __restrict__ PC, const float* __restrict__ AGG, const bf16* __restrict__ PROJ, bf16* __restrict__ LRUO,
                                         const bf16* __restrict__ OG, const float* __restrict__ LSE, bf16* __restrict__ ATT, int G, int tid, int do_merge) {
    for (int U0 = (int)blockIdx.x; U0 < 256; U0 += G) { const int U = G == 256 ? team_rows64(U0) : U0;
        const int half = U & 1, idx = U >> 1, b = idx >> 6, ck = idx & 63, c0 = 8 * (tid & 127), rg = tid >> 7;
        float cr[8];
#pragma unroll
        for (int q = 0; q < 8; ++q) cr[q] = 0.f;
#pragma unroll 8
        for (int k = 0; k < ck; ++k) { const float* ap = AGG + ((size_t)(b * 64 + k) * 2) * 1024 + c0; const f32x4 a0 = *(const f32x4*)ap, a1 = *(const f32x4*)(ap + 4), b0 = *(const f32x4*)(ap + 1024), b1 = *(const f32x4*)(ap + 1028);
            cr[0] = a0.x * cr[0] + b0.x; cr[1] = a0.y * cr[1] + b0.y; cr[2] = a0.z * cr[2] + b0.z; cr[3] = a0.w * cr[3] + b0.w; cr[4] = a1.x * cr[4] + b1.x; cr[5] = a1.y * cr[5] + b1.y; cr[6] = a1.z * cr[6] + b1.z; cr[7] = a1.w * cr[7] + b1.w; }
        const size_t row0 = (size_t)b * SEQ + ck * 128 + half * 64 + rg * 16;
#pragma unroll 8
        for (int i = 0; i < 16; ++i) { const size_t r = row0 + i;
            const u32x4 hl = *(const u32x4*)(HL + r * DM + c0), gg = *(const u32x4*)(PROJ + r * INW + C_GL + c0); const u32x2 pc = *(const u32x2*)((const unsigned char*)PC + r * DM + c0);
            u32x4 o;
            constexpr float S = 1.0f / 255.0f;
            o.x = cvt_pk_bf16((bflo(hl.x) + ub0(pc.x) * S * cr[0]) * gelu_tanh_f(bflo(gg.x)), (bfhi(hl.x) + ub1(pc.x) * S * cr[1]) * gelu_tanh_f(bfhi(gg.x)));
            o.y = cvt_pk_bf16((bflo(hl.y) + ub2(pc.x) * S * cr[2]) * gelu_tanh_f(bflo(gg.y)), (bfhi(hl.y) + ub3(pc.x) * S * cr[3]) * gelu_tanh_f(bfhi(gg.y)));
            o.z = cvt_pk_bf16((bflo(hl.z) + ub0(pc.y) * S * cr[4]) * gelu_tanh_f(bflo(gg.z)), (bfhi(hl.z) + ub1(pc.y) * S * cr[5]) * gelu_tanh_f(bfhi(gg.z)));
            o.w = cvt_pk_bf16((bflo(hl.w) + ub2(pc.y) * S * cr[6]) * gelu_tanh_f(bflo(gg.w)), (bfhi(hl.w) + ub3(pc.y) * S * cr[7]) * gelu_tanh_f(bfhi(gg.w)));
            st_wt16(LRUO + r * CAW + c0, o); }
    }
    if (do_merge) for (int it0 = (int)blockIdx.x * 512 + tid; it0 < M * 32; it0 += G * 512) { const int it = G == 256 ? (team_rows64((int)blockIdx.x) * 2048 + (it0 - (int)blockIdx.x * 512) / (G * 512) * 512 + tid) : it0;
        const int row = it >> 5, cg = it & 31, hh = cg >> 3;
        const int bb = row >> 13, tt = row & (SEQ - 1);
        float lv[3];
#pragma unroll
        for (int g = 0; g < 3; ++g) { const int dsh = 2 * g, r = tt & ((1 << dsh) - 1), m = tt >> dsh, nblk = m >> 7, qi = m & 127, combo = r * (64 >> dsh) + nblk;
            lv[g] = LSE[(size_t)((((bb * 3 + g) << 8) | (combo << 2) | hh)) * 128 + qi]; }
        const float l0 = lv[0], l1 = lv[1], l2 = lv[2];
        const float ml = fmaxf(fmaxf(l0, l1), l2); float w0 = __expf(l0 - ml), w1 = __expf(l1 - ml), w2 = __expf(l2 - ml); const float wi = 1.0f / (w0 + w1 + w2); w0 *= wi; w1 *= wi; w2 *= wi;
        const u32x4 o0 = *(const u32x4*)(OG + (size_t)row * 256 + cg * 8), o1 = *(const u32x4*)(OG + ((size_t)M + row) * 256 + cg * 8), o2 = *(const u32x4*)(OG + ((size_t)2 * M + row) * 256 + cg * 8);
        u32x4 o;
        o.x = cvt_pk_bf16(w0 * bflo(o0.x) + w1 * bflo(o1.x) + w2 * bflo(o2.x), w0 * bfhi(o0.x) + w1 * bfhi(o1.x) + w2 * bfhi(o2.x));
        o.y = cvt_pk_bf16(w0 * bflo(o0.y) + w1 * bflo(o1.y) + w2 * bflo(o2.y), w0 * bfhi(o0.y) + w1 * bfhi(o1.y) + w2 * bfhi(o2.y));
        o.z = cvt_pk_bf16(w0 * bflo(o0.z) + w1 * bflo(o1.z) + w2 * bflo(o2.z), w0 * bfhi(o0.z) + w1 * bfhi(o1.z) + w2 * bfhi(o2.z));
        o.w = cvt_pk_bf16(w0 * bflo(o0.w) + w1 * bflo(o1.w) + w2 * bflo(o2.w), w0 * bfhi(o0.w) + w1 * bfhi(o1.w) + w2 * bfhi(o2.w));
        st_wt16(ATT + (size_t)row * CAW + cg * 8, o);
    }
}

constexpr int RT_LG = 0, RT_SS = RT_LG + 2 * 64 * 48 * 4, RT_CNT = RT_SS + 2 * 64 * 4, RT_BASE = RT_CNT + 32 * 4;
__device__ __forceinline__ void ph_router(const float* __restrict__ X1, const bf16* __restrict__ DELTA, bf16* __restrict__ X1B, const P& p, unsigned char* __restrict__ H2, int* __restrict__ ROUTE, int* __restrict__ TOK, unsigned* __restrict__ cnt, LAS unsigned char* lds, int G, int tid) {
    const float* g2 = p.in[14]; const bf16* WRT = (const bf16*)(p.ws + WS_WRT);
    const int lane = tid & 63, w = __builtin_amdgcn_readfirstlane(tid >> 6), fr = lane & 15, fq = lane >> 4, rt = w & 3, kh = w >> 2;
    LAS float* LG = (LAS float*)(lds + RT_LG); LAS float* SS = (LAS float*)(lds + RT_SS); LAS unsigned* LC = (LAS unsigned*)(lds + RT_CNT); LAS unsigned* LB = (LAS unsigned*)(lds + RT_BASE);
    for (int rb0 = (int)blockIdx.x; rb0 < M / 64; rb0 += G) { const int rb = G == 256 ? team_rows64(rb0) : rb0;
        const int row = rb * 64 + 16 * rt + fr; const float* xp = X1 + (size_t)row * DM + kh * 512 + 8 * fq;
        f32x4 xs[16][2];
#pragma unroll
        for (int ks = 0; ks < 16; ++ks) { xs[ks][0] = *(const f32x4*)(xp + 32 * ks); xs[ks][1] = *(const f32x4*)(xp + 32 * ks + 4); }
        { const bf16* dp = DELTA + (size_t)row * DM + kh * 512 + 8 * fq;
#pragma unroll
            for (int ks = 0; ks < 16; ++ks) { const u32x4 d = *(const u32x4*)(dp + 32 * ks);
                xs[ks][0].x += bflo(d.x); xs[ks][0].y += bfhi(d.x); xs[ks][0].z += bflo(d.y); xs[ks][0].w += bfhi(d.y); xs[ks][1].x += bflo(d.z); xs[ks][1].y += bfhi(d.z); xs[ks][1].z += bflo(d.w); xs[ks][1].w += bfhi(d.w); } }
        if (tid < 32) LC[tid] = 0u;
        f32x4 acc[3]; acc[0] = (f32x4){0.f, 0.f, 0.f, 0.f}; acc[1] = acc[0]; acc[2] = acc[0]; float ss = 0.f;
        const bf16* wq = WRT + ((kh * 16) * 96 + fr) * 32 + 8 * fq;
        bf16* xb = X1B + (size_t)row * DM + kh * 512 + 8 * fq;
        bf16x8 bh[2][3], bl[2][3];
#pragma unroll
        for (int ct = 0; ct < 3; ++ct) { bh[0][ct] = *(const bf16x8*)(wq + ct * 16 * 32); bl[0][ct] = *(const bf16x8*)(wq + (48 + ct * 16) * 32); }
#pragma unroll
        for (int ks = 0; ks < 16; ++ks) {
            wq += 96 * 32; asm volatile("" : "+v"(wq) :: "memory");
            if (ks < 15) {
#pragma unroll
                for (int ct = 0; ct < 3; ++ct) { bh[(ks + 1) & 1][ct] = *(const bf16x8*)(wq + ct * 16 * 32); bl[(ks + 1) & 1][ct] = *(const bf16x8*)(wq + (48 + ct * 16) * 32); } }
            const f32x4 x0 = xs[ks][0], x1 = xs[ks][1];
            ss += (x0.x * x0.x + x0.y * x0.y) + (x0.z * x0.z + x0.w * x0.w) + (x1.x * x1.x + x1.y * x1.y) + (x1.z * x1.z + x1.w * x1.w);
            u32x4 hi, lo;
            hi.x = cvt_pk_bf16(x0.x, x0.y); hi.y = cvt_pk_bf16(x0.z, x0.w); hi.z = cvt_pk_bf16(x1.x, x1.y); hi.w = cvt_pk_bf16(x1.z, x1.w);
            lo.x = cvt_pk_bf16(x0.x - bflo(hi.x), x0.y - bfhi(hi.x)); lo.y = cvt_pk_bf16(x0.z - bflo(hi.y), x0.w - bfhi(hi.y));
            lo.z = cvt_pk_bf16(x1.x - bflo(hi.z), x1.y - bfhi(hi.z)); lo.w = cvt_pk_bf16(x1.z - bflo(hi.w), x1.w - bfhi(hi.w));
            *(u32x4*)(xb + 32 * ks) = hi;
            const bf16x8 ah = __builtin_bit_cast(bf16x8, hi), al = __builtin_bit_cast(bf16x8, lo);
#pragma unroll
            for (int ct = 0; ct < 3; ++ct) {
                acc[ct] = __builtin_amdgcn_mfma_f32_16x16x32_bf16(ah, bh[ks & 1][ct], acc[ct], 0, 0, 0);
                acc[ct] = __builtin_amdgcn_mfma_f32_16x16x32_bf16(ah, bl[ks & 1][ct], acc[ct], 0, 0, 0);
                acc[ct] = __builtin_amdgcn_mfma_f32_16x16x32_bf16(al, bh[ks & 1][ct], acc[ct], 0, 0, 0); } }
        ss += __shfl_xor(ss, 16); ss += __shfl_xor(ss, 32);
#pragma unroll
        for (int ct = 0; ct < 3; ++ct)
#pragma unroll
            for (int i = 0; i < 4; ++i) LG[(kh * 64 + 16 * rt + 4 * fq + i) * 48 + 16 * ct + fr] = acc[ct][i];
        if (fq == 0) SS[kh * 64 + 16 * rt + fr] = ss;
        __syncthreads();
        const float rinv = 1.0f / sqrtf((SS[16 * rt + fr] + SS[64 + 16 * rt + fr]) * (1.f / DM) + EPS);
        unsigned char* hp = H2 + (size_t)row * DM + kh * 512 + 8 * fq; const float* gp = g2 + kh * 512 + 8 * fq;
#pragma unroll
        for (int ks = 0; ks < 16; ++ks) { const f32x4 ga = *(const f32x4*)(gp + 32 * ks), gb = *(const f32x4*)(gp + 32 * ks + 4); const f32x4 x0 = xs[ks][0], x1 = xs[ks][1];
            u32x2 o; o.x = pk4_fp8(x0.x * rinv * ga.x, x0.y * rinv * ga.y, x0.z * rinv * ga.z, x0.w * rinv * ga.w); o.y = pk4_fp8(x1.x * rinv * gb.x, x1.y * rinv * gb.y, x1.z * rinv * gb.z, x1.w * rinv * gb.w);
            *(u32x2*)(hp + 32 * ks) = o; asm volatile("" ::: "memory"); }
        if (w == 0) {
            const int r = rb * 64 + lane; const float ri = 1.0f / sqrtf((SS[lane] + SS[64 + lane]) * (1.f / DM) + EPS);
            const LAS float* l0 = LG + lane * 48; const LAS float* l1 = LG + (64 + lane) * 48;
            float lgt[4];
#pragma unroll
            for (int c = 0; c < 4; ++c) lgt[c] = (l0[c] + l1[c]) * ri;
            int gs = 0; float gm = lgt[0];
#pragma unroll
            for (int c = 1; c < 4; ++c) if (lgt[c] > gm) { gm = lgt[c]; gs = c; }
            float den = 0.f;
#pragma unroll
            for (int c = 0; c < 4; ++c) den += expf(lgt[c] - gm);
            const float psel = 1.0f / den;
            float ls[8];
#pragma unroll
            for (int c = 0; c < 8; ++c) ls[c] = (l0[4 + gs * 8 + c] + l1[4 + gs * 8 + c]) * ri;
            int i1 = 0; float v1 = ls[0];
#pragma unroll
            for (int c = 1; c < 8; ++c) if (ls[c] > v1) { v1 = ls[c]; i1 = c; }
            int i2 = -1; float v2 = -3.0e38f;
#pragma unroll
            for (int c = 0; c < 8; ++c) if (c != i1 && ls[c] > v2) { v2 = ls[c]; i2 = c; }
            const float e2 = expf(v2 - v1); const float w1 = psel / (1.f + e2), w2 = psel * e2 / (1.f + e2);
            const int ea = gs * 8 + i1, eb = gs * 8 + i2;
            const unsigned la = __hip_atomic_fetch_add(LC + ea, 1u, __ATOMIC_RELAXED, __HIP_MEMORY_SCOPE_WORKGROUP);
            const unsigned lb = __hip_atomic_fetch_add(LC + eb, 1u, __ATOMIC_RELAXED, __HIP_MEMORY_SCOPE_WORKGROUP);
            asm volatile("s_waitcnt lgkmcnt(0)" ::: "memory");
            if (lane < 32) { const unsigned n = LC[lane]; LB[lane] = n ? atomicAdd(cnt + lane, n) : 0u; }
            asm volatile("s_waitcnt vmcnt(0) lgkmcnt(0)" ::: "memory");
            const int sa = (int)(LB[ea] + la), sb = (int)(LB[eb] + lb);
            __hip_atomic_store(TOK + ea * CAP + sa, r, __ATOMIC_RELAXED, __HIP_MEMORY_SCOPE_AGENT); __hip_atomic_store(TOK + eb * CAP + sb, r, __ATOMIC_RELAXED, __HIP_MEMORY_SCOPE_AGENT);
            int* rr = ROUTE + (size_t)r * 8; rr[0] = ea; rr[1] = eb; rr[2] = sa; rr[3] = sb; ((float*)rr)[4] = w1; ((float*)rr)[5] = w2;
        }
        __syncthreads();
    }
}

__device__ __forceinline__ void ph_final(const bf16* __restrict__ X1B, float* __restrict__ OUT, const unsigned char* __restrict__ Y, const int* __restrict__ ROUTE, const unsigned* __restrict__ cnt, const float* __restrict__ gf, int gw, int NGW, int lane) {
    int tiles = lane < NEXP ? (int)((cnt[lane] + 255u) >> 8) : 0; int incl = tiles;
#pragma unroll
    for (int o = 1; o < 32; o <<= 1) { const int n = __shfl_up(incl, o); if (lane >= o) incl += n; }
    const int cbase = (incl - tiles) * 256;
    f32x4 g[4];
#pragma unroll
    for (int j = 0; j < 4; ++j) g[j] = *((const f32x4*)gf + lane + 64 * j);
    for (int row0 = gw * 4; row0 < M; row0 += NGW * 4) {
        int ea = 0, eb = 0, sa = 0, sb = 0; float w1 = 0.f, w2 = 0.f;
        if (lane < 4) { const int* r = ROUTE + (size_t)(row0 + lane) * 8; const u32x4 a = *(const u32x4*)r; const f32x2 b = *(const f32x2*)(r + 4); ea = (int)a.x; eb = (int)a.y; sa = (int)a.z; sb = (int)a.w; w1 = b.x; w2 = b.y; }
        const int pa = __shfl(cbase, ea) + sa, pb = __shfl(cbase, eb) + sb;
        f32x4 v[4][4]; unsigned ya[4][4], yb[4][4]; u32x2 dl[4][4]; float wa[4], wb[4];
#pragma unroll
        for (int q = 0; q < 4; ++q) { const int qa = __shfl(pa, q), qb = __shfl(pb, q); wa[q] = __shfl(w1, q) * YINV; wb[q] = __shfl(w2, q) * YINV;
            const unsigned* pya = (const unsigned*)(Y + (size_t)qa * DM) + lane; const unsigned* pyb = (const unsigned*)(Y + (size_t)qb * DM) + lane;
#pragma unroll
            for (int j = 0; j < 4; ++j) { ya[q][j] = pya[64 * j]; yb[q][j] = pyb[64 * j]; dl[q][j] = *((const u32x2*)(X1B + (size_t)(row0 + q) * DM) + lane + 64 * j); } }
        float s[4];
#pragma unroll
        for (int q = 0; q < 4; ++q) { s[q] = 0.f;
#pragma unroll
            for (int j = 0; j < 4; ++j) { const u32x2 d = dl[q][j]; f32x4 t; t.x = bflo(d.x); t.y = bfhi(d.x); t.z = bflo(d.y); t.w = bfhi(d.y);
                const f32x2 a0 = __builtin_amdgcn_cvt_pk_f32_fp8((int)ya[q][j], false), a1 = __builtin_amdgcn_cvt_pk_f32_fp8((int)ya[q][j], true), b0 = __builtin_amdgcn_cvt_pk_f32_fp8((int)yb[q][j], false), b1 = __builtin_amdgcn_cvt_pk_f32_fp8((int)yb[q][j], true);
                t.x += wa[q] * a0.x + wb[q] * b0.x; t.y += wa[q] * a0.y + wb[q] * b0.y; t.z += wa[q] * a1.x + wb[q] * b1.x; t.w += wa[q] * a1.y + wb[q] * b1.y;
                v[q][j] = t; s[q] += (t.x * t.x + t.y * t.y) + (t.z * t.z + t.w * t.w); }
            asm volatile("" : "+v"(s[q]) :: "memory"); }
#pragma unroll
        for (int o = 1; o < 64; o <<= 1) { s[0] += __shfl_xor(s[0], o); s[1] += __shfl_xor(s[1], o); s[2] += __shfl_xor(s[2], o); s[3] += __shfl_xor(s[3], o); }
#pragma unroll
        for (int q = 0; q < 4; ++q) { const float rinv = 1.0f / sqrtf(s[q] * (1.f / DM) + EPS); f32x4* xr = (f32x4*)(OUT + (size_t)(row0 + q) * DM) + lane;
#pragma unroll
            for (int j = 0; j < 4; ++j) { f32x4 o; o.x = v[q][j].x * rinv * g[j].x; o.y = v[q][j].y * rinv * g[j].y; o.z = v[q][j].z * rinv * g[j].z; o.w = v[q][j].w * rinv * g[j].w; xr[64 * j] = o; } }
    }
}

constexpr int NPHASE = 9;
__global__ void __launch_bounds__(512, 2) mega_fwd(P p) {
    extern __shared__ __attribute__((aligned(16))) unsigned char lds_raw[];
    LAS unsigned char* lds = (LAS unsigned char*)lds_raw;
    const int G = (int)gridDim.x;
#define IDS() const int tid = fresh_tid(), lane = tid & 63, wave = __builtin_amdgcn_readfirstlane(tid >> 6), gw = (int)blockIdx.x * NWAVES + wave, NGW = G * NWAVES, gt = (int)blockIdx.x * 512 + tid, NGT = G * 512; (void)lane; (void)gw; (void)NGW; (void)gt; (void)NGT
    unsigned char* ws = p.ws;
    gu32* ctl = (gu32*)(ws + WS_CTL);
    { IDS(); for (int u = tid; u < (LDS_BYTES - 131072) / 4; u += 512) ((LAS unsigned*)(lds + 131072))[u] = 0u; }
    __syncthreads();
    volatile LAS unsigned* MISC = (volatile LAS unsigned*)(lds + MISC_OFF);
    XcdBarrier bar = xcd_barrier_post((unsigned*)ctl + CW_BAR, MISC + 8);
    const int lo = p.ph_lo, hi = p.ph_hi;
#define IN(k) (lo <= (k) && (k) < hi)
    bf16* PROJ = (bf16*)(ws + WS_PROJ); bf16* H = (bf16*)(ws + WS_H); unsigned* cnt = (unsigned*)(ws + WS_CTL) + CW_CNT;
    LAS int* tab = (LAS int*)(lds + TAB_OFF);

#define RUN(k, BODY) do { if (IN(k)) { BODY; if (REPEAT_PHASE == (k)) { xcd_barrier(bar); BODY; } } if (IN(k) && IN((k) + 1)) { if (G == 256 && (k) >= 3 && (k) <= 5) team_barrier((unsigned*)ctl, 4u * ((k) - 2)); else xcd_barrier(bar); } } while (0)
#define PHASE_0 { IDS(); ph_prologue(p, lds, gw, NGW, wave, lane); }
#define PHASE_1 { const int NG = G >= 256 ? 229 : G; const int NA = G >= 256 ? MOE_ITEMS_A : 0; const int NB = G >= 256 ? MOE_ITEMS_B : 0;     \
        if ((int)blockIdx.x < NG) { pg8::Gemm g{H, (const bf16*)(ws + WS_WIN), M, INW, 1024, 0}; EpiProj E{PROJ}; pg8::StaticOrder S; S.init(M, INW, 2048, NG, (int)blockIdx.x); \
            pg8::gemm_phase<EpiProj, pg8::StaticOrder, false, true, true>(lds, g, S, E); } \
        else { IDS(); ph_moe_convert(p, lds, 0, NA, ((int)blockIdx.x - NG) * NWAVES + wave, (G - NG) * NWAVES, wave, lane); } \
        { IDS(); ph_moe_convert(p, lds, NB, N_MOE_ITEMS, gw, NGW, wave, lane); } }
#define PHASE_2 { const int NC = G >= 256 ? 224 : G;       \
        if ((int)blockIdx.x < NC) { ph_attention(PROJ, p.in[1], (bf16*)(ws + WS_OG), (float*)(ws + WS_LSE), lds, ((int)blockIdx.x + (NC - 32)) % NC, NC, fresh_tid());     \
            ph_lru_local(PROJ, p, (bf16*)(ws + WS_HL), (bf16*)(ws + WS_PC), (float*)(ws + WS_AGG), lds, (int)blockIdx.x, NC, fresh_tid()); } \
        else { IDS(); ph_moe_convert(p, lds, MOE_ITEMS_A, MOE_ITEMS_B, ((int)blockIdx.x - NC) * NWAVES + wave, (G - NC) * NWAVES, wave, lane); } }
#define PHASE_3 { ph_fixup((const bf16*)(ws + WS_HL), (const bf16*)(ws + WS_PC), (const float*)(ws + WS_AGG), PROJ, (bf16*)(ws + WS_CA), (const bf16*)(ws + WS_OG), (const float*)(ws + WS_LSE), (bf16*)(ws + WS_CA) + 1024, G, fresh_tid(), 1); }
#define PHASE_4 { pg8::Gemm g{(const bf16*)(ws + WS_CA), (const bf16*)(ws + WS_WPLA), M, 1024, CAW, 0}; EpiGateMid E{(bf16*)(ws + WS_MERGED), PROJ, 0, 1024}; pg8::StaticOrder S; S.init(M, 1024, CAW * 2, G, (int)blockIdx.x); \
        pg8::gemm_phase<EpiGateMid, pg8::StaticOrder, false, false, true>(lds, g, S, E); }
#define PHASE_5 { pg8::Gemm g{(const bf16*)(ws + WS_MERGED), (const bf16*)(ws + WS_WOUT), M, 1024, 1024, 0}; EpiPlain E{(bf16*)(ws + WS_DELTA), 1024, 1.0f}; pg8::StaticOrder S; S.init(M, 1024, 2048, G, (int)blockIdx.x); \
        pg8::gemm_phase<EpiPlain, pg8::StaticOrder, false, false, true>(lds, g, S, E); }
#define PHASE_6 { ph_router(p.in[0], (const bf16*)(ws + WS_DELTA), (bf16*)(ws + WS_X1B), p, (unsigned char*)H, (int*)(ws + WS_ROUTE), (int*)(ws + WS_TOK), cnt, lds, G, fresh_tid()); }
#define PHASE_7 { build_moe_table(tab, cnt, fresh_tid()); __syncthreads(); \
        { pg8::Gemm g{H, (const bf16*)(ws + WS_WGU), MAXTILES * 256, 1024, 1024, 0}; EpiSwiglu E{ws + WS_ACT}; \
          MoeOrderT<0> S; S.tab = tab; S.tok = (const int*)(ws + WS_TOK); S.cnt = cnt; S.ctl = (unsigned*)ctl; S.G = G; S.c = (int)blockIdx.x; S.rb = 1024; S.gather = 1; S.bstride = (size_t)1024 * 1024; \
          pg8::gemm_phase<EpiSwiglu, MoeOrderT<0>, true, true, true>(lds, g, S, E); } \
        { pg8::Gemm g{(const bf16*)(ws + WS_ACT), (const bf16*)(ws + WS_WD), MAXTILES * 256, 1024, 512, 0}; EpiY8 E{ws + WS_Y, WINV * YSCALE}; \
          MoeOrderT<1> S; S.tab = tab; S.tok = (const int*)(ws + WS_TOK); S.cnt = cnt; S.ctl = (unsigned*)ctl; S.G = G; S.c = (int)blockIdx.x; S.rb = 512; S.gather = 0; S.bstride = (size_t)1024 * 512; \
          pg8::gemm_phase<EpiY8, MoeOrderT<1>, true, true, true>(lds, g, S, E); } }
#define PHASE_8 { IDS(); ph_final((const bf16*)(ws + WS_X1B), p.out, ws + WS_Y, (const int*)(ws + WS_ROUTE), cnt, p.in[19], gw, NGW, lane); }
    RUN(0, PHASE_0); RUN(1, PHASE_1);
    RUN(2, PHASE_2); RUN(3, PHASE_3); RUN(4, PHASE_4); RUN(5, PHASE_5); RUN(6, PHASE_6); RUN(7, PHASE_7); RUN(8, PHASE_8);
#undef IN
#undef IDS
}

#ifndef MK_PER_PHASE
#define MK_PER_PHASE 0
#endif
extern "C" void kernel_launch(void* const* d_in, const int* in_sizes, int n_in, void* d_out, int out_size, void* d_ws, size_t ws_size, hipStream_t stream) {
    static int grid = 0;
    if (grid == 0) {
        if (n_in != 20 || out_size != M * DM || ws_size < WS_END) { fprintf(stderr, "kernel_launch: unexpected shapes (n_in %d out %d ws %zu)\n", n_in, out_size, ws_size); grid = -1; return; }
        int dev = 0, cus = 0, per_cu = 0; if (hipGetDevice(&dev) != hipSuccess || hipDeviceGetAttribute(&cus, hipDeviceAttributeMultiprocessorCount, dev) != hipSuccess) { grid = -1; return; }
        if (hipFuncSetAttribute((const void*)mega_fwd, hipFuncAttributeMaxDynamicSharedMemorySize, LDS_BYTES) != hipSuccess) { grid = -1; return; }
        if (hipOccupancyMaxActiveBlocksPerMultiprocessor(&per_cu, (const void*)mega_fwd, 512, LDS_BYTES) != hipSuccess || per_cu < 1) { fprintf(stderr, "kernel_launch: occupancy query says %d\n", per_cu); (void)hipGetLastError(); grid = -1; return; }
        grid = cus;
    }
    if (grid < 0) return;
    unsigned char* ws = (unsigned char*)d_ws;
    (void)hipMemsetAsync(ws + WS_CTL, 0, CTL_ZERO_BYTES, stream);
    P p{}; for (int i = 0; i < 20; ++i) p.in[i] = (const float*)d_in[i]; p.out = (float*)d_out; p.ws = ws;
#if MK_PER_PHASE
    for (int k = 0; k < NPHASE; ++k) { p.ph_lo = k; p.ph_hi = k + 1; hipLaunchKernelGGL(mega_fwd, dim3(grid), dim3(512), LDS_BYTES, stream, p); }
#else
    p.ph_lo = 0; p.ph_hi = NPHASE; hipLaunchKernelGGL(mega_fwd, dim3(grid), dim3(512), LDS_BYTES, stream, p);
#endif
}
```

```cpp
#include <hip/hip_runtime.h>
#include <cstdio>
#include <cstdint>

__device__ __forceinline__ int fresh_tid() { int t = (int)threadIdx.x; asm volatile("" : "+v"(t)); return t; }
namespace pg8 {
#define PG8_LAS __attribute__((address_space(3)))
typedef unsigned short bf16_t;
typedef short bf16x8 __attribute__((ext_vector_type(8)));
typedef float f32x4 __attribute__((ext_vector_type(4)));
typedef float f32x2 __attribute__((ext_vector_type(2)));
typedef unsigned u32x4 __attribute__((ext_vector_type(4)));
typedef unsigned u32x2 __attribute__((ext_vector_type(2)));
constexpr int BM = 256, BK = 64, HALF = 128, HTB = HALF * BK * 2  , STAGE_BYTES = 8 * HTB, NXCD = 8, WGM = 8;

__host__ __device__ __forceinline__ int lds_byte(int r, int c) { const int st = (r >> 4) * 2 + (c >> 5), rr = r & 15, cc = c & 31, ob = rr * 64 + cc * 2; return st * 1024 + (ob ^ (((ob >> 9) & 1) << 5)); }
__host__ __device__ __forceinline__ void stage_rc(int b, int& R, int& C) { const int st = b / 1024, sb = b % 1024, swz = sb ^ (((sb >> 9) & 1) << 5); R = (st >> 1) * 16 + swz / 64; C = (st & 1) * 32 + (swz % 64) / 2; }
__host__ __device__ __forceinline__ int perm32(int rho) { const int n = rho >> 4, i = rho & 15; return 8 * (i >> 2) + 4 * n + (i & 3); }

struct Unit { int pm, pn, e, r0; };
struct Gemm { const bf16_t* A; const bf16_t* Bt; int M, N, K, pad; };

struct StaticOrder {
    int nM, nN, nwg, G, c, rb;
    __host__ __device__ void init(int M, int N, int rb_, int G_, int c_) { nM = M / BM; nN = N / BM; nwg = nM * nN; G = G_; c = c_; rb = rb_; }
    __device__ __forceinline__ bool next(int i, Unit& u) const {
        const long L = (long)i * G + c; if (L >= nwg) return false;
        int wgid = (int)L; { const int q = nwg / NXCD, r = nwg % NXCD, xcd = wgid % NXCD, off = wgid / NXCD; wgid = (xcd < r ? xcd * (q + 1) : r * (q + 1) + (xcd - r) * q) + off; }
        const int nig = WGM * nN, gid = wgid / nig, fm = gid * WGM, gsz = (nM - fm) < WGM ? (nM - fm) : WGM;
        u.pm = fm + ((wgid % nig) % gsz); u.pn = (wgid % nig) / gsz; u.e = 0; u.r0 = 0; return true;
    }
    __device__ __forceinline__ unsigned a_off(const Unit& u, int r) const { return (unsigned)(u.pm * BM + r) * (unsigned)rb; }
    __device__ __forceinline__ size_t b_off(const Unit& u) const { return (size_t)u.pn * BM * rb; }
    static constexpr int A_AUX = 0; static constexpr bool HANDOFF = false;
    __device__ __forceinline__ unsigned poll_begin(const Unit&) const { return 0u; }
    __device__ __forceinline__ void poll_end(const Unit&, unsigned) const {}
    __device__ __forceinline__ void publish(int) const {}
};

__device__ __forceinline__ unsigned cvt_pk_bf16(float lo, float hi) { unsigned r; asm volatile("v_cvt_pk_bf16_f32 %0, %1, %2" : "=v"(r) : "v"(lo), "v"(hi)); return r; }

typedef int i32x8 __attribute__((ext_vector_type(8)));
template <class Epi, class Sched, bool FP8 = false, bool ALIGN_EPI = false, bool SP2 = false>
__device__ __forceinline__ void gemm_phase(PG8_LAS unsigned char* lds, const Gemm g, const Sched& S, const Epi& E) {
    const int tid = fresh_tid(), wid = __builtin_amdgcn_readfirstlane(tid >> 6), lane = tid & 63, wr = wid >> 2, wc = wid & 3, fr = lane & 15, fq = lane >> 4;
    const int RB = FP8 ? g.K : g.K * 2, nt = RB / (BK * 2);
    unsigned voffB[2];
#pragma unroll
    for (int i = 0; i < 2; ++i) { int R, C; stage_rc(tid * 16 + i * 8192, R, C); const int Rb = Epi::PERM ? ((R & ~31) + perm32(R & 31)) : R;
        voffB[i] = (unsigned)(Rb * RB + C * 2); }
#define PG8_AOFFS(U, A0, A1) do { const int _t = fresh_tid(); _Pragma("unroll") for (int i = 0; i < 2; ++i) { int R, C; stage_rc(_t * 16 + i * 8192, R, C); A0[i] = S.a_off(U, R) + (unsigned)C * 2u; A1[i] = S.a_off(U, HALF + R) + (unsigned)C * 2u; } } while (0)
    const size_t kstep = (size_t)(BK * 2);
    const size_t hstep = (size_t)HALF * RB;
    const unsigned ldsw = (unsigned)wid * 1024u;
    const int aoff = lds_byte(wr * 64 + fr, fq * 8), boff = lds_byte(wc * 32 + fr, fq * 8);
    const int aoff8 = lds_byte(wr * 64 + fr, fq * 16), boff8 = lds_byte(wc * 32 + fr, fq * 16);
#define PG8_SA(b, h) (((b) * 2 + (h)) * HTB)
#define PG8_SB(b, h) ((4 + (b) * 2 + (h)) * HTB)
#define PG8_STAGE(bufoff, gbase, voff) do { _Pragma("unroll") for (int _i = 0; _i < 2; ++_i) \
        __builtin_amdgcn_global_load_lds((const unsigned*)((const char*)(gbase) + (voff)[_i]), (PG8_LAS unsigned*)(lds + (bufoff) + ldsw + _i * 8192), 16, 0, 0); } while (0)
#define PG8_STAGE_A(bufoff, gbase, voff) do { _Pragma("unroll") for (int _i = 0; _i < 2; ++_i) \
        __builtin_amdgcn_global_load_lds((const unsigned*)((const char*)(gbase) + (voff)[_i]), (PG8_LAS unsigned*)(lds + (bufoff) + ldsw + _i * 8192), 16, 0, Sched::A_AUX); } while (0)
#define PG8_LDA(dst, b, h) do { if constexpr (FP8) { _Pragma("unroll") for (int m = 0; m < 4; ++m) dst##8[m] = *(const PG8_LAS i32x8*)(lds + PG8_SA(b, h) + aoff8 + m * 2048); } \
        else { _Pragma("unroll") for (int m = 0; m < 4; ++m) _Pragma("unroll") for (int k = 0; k < 2; ++k) dst[m][k] = *(const PG8_LAS bf16x8*)(lds + PG8_SA(b, h) + aoff + m * 2048 + k * 1024); } } while (0)
#define PG8_LDB(dst, b, h) do { if constexpr (FP8) { _Pragma("unroll") for (int n = 0; n < 2; ++n) dst##8[n] = *(const PG8_LAS i32x8*)(lds + PG8_SB(b, h) + boff8 + n * 2048); } \
        else { _Pragma("unroll") for (int n = 0; n < 2; ++n) _Pragma("unroll") for (int k = 0; k < 2; ++k) dst[n][k] = *(const PG8_LAS bf16x8*)(lds + PG8_SB(b, h) + boff + n * 2048 + k * 1024); } } while (0)
#define PG8_MMA(ai, bj, At, Bt) do { __builtin_amdgcn_s_setprio(1); if constexpr (FP8) { _Pragma("unroll") for (int m = 0; m < 4; ++m) _Pragma("unroll") for (int n = 0; n < 2; ++n) \
            asm volatile("v_mfma_f32_16x16x128_f8f6f4 %0, %1, %2, %0" : "+v"(acc[ai][bj][m][n]) : "v"(Bt##8[n]), "v"(At##8[m]));     } \
        else { _Pragma("unroll") for (int m = 0; m < 4; ++m) _Pragma("unroll") for (int n = 0; n < 2; ++n) _Pragma("unroll") for (int k = 0; k < 2; ++k) \
            acc[ai][bj][m][n] = __builtin_amdgcn_mfma_f32_16x16x32_bf16(Bt[n][k], At[m][k], acc[ai][bj][m][n], 0, 0, 0); } __builtin_amdgcn_s_setprio(0); } while (0)
#define PG8_STAGE_SEL(bufoff, gbase, va, vb) do { _Pragma("unroll") for (int _i = 0; _i < 2; ++_i) \
        __builtin_amdgcn_global_load_lds((const unsigned*)((const char*)(gbase) + (last ? (vb)[_i] : (va)[_i])), (PG8_LAS unsigned*)(lds + (bufoff) + ldsw + _i * 8192), 16, 0, Sched::A_AUX); } while (0)
#define PG8_WAIT_V(n) asm volatile("s_waitcnt vmcnt(" #n ")" ::: "memory")
#define PG8_WAIT_L(n) asm volatile("s_waitcnt lgkmcnt(" #n ")" ::: "memory")
#define PG8_BAR __builtin_amdgcn_s_barrier()
#define PG8_SCHED __builtin_amdgcn_sched_barrier(0)
    Unit cur, nxt; int ui = 0;
    if (!S.next(0, cur)) return;
    f32x4 acc[2][2][4][2];
#pragma unroll
    for (int a = 0; a < 2; ++a)
#pragma unroll
        for (int b = 0; b < 2; ++b)
#pragma unroll
            for (int m = 0; m < 4; ++m)
#pragma unroll
                for (int n = 0; n < 2; ++n) acc[a][b][m][n] = (f32x4){0.f, 0.f, 0.f, 0.f};
    bf16x8 At[4][2], B0[2][2], B1[2][2]; i32x8 At8[4], B08[2], B18[2];
    unsigned cA0[2], cA1[2], nA0[2], nA1[2];
    PG8_AOFFS(cur, cA0, cA1);
    const char* gA = (const char*)g.A;
    const char* cB = (const char*)g.Bt + S.b_off(cur);
    S.poll_end(cur, S.poll_begin(cur));
    int pend = -1;
    if constexpr (SP2) {
        PG8_STAGE(PG8_SB(0, 0), cB, voffB); PG8_STAGE(PG8_SB(0, 1), cB + hstep, voffB); PG8_STAGE_A(PG8_SA(0, 0), gA, cA0); PG8_STAGE_A(PG8_SA(0, 1), gA, cA1);
        if (wr == 1) PG8_BAR;
        PG8_WAIT_V(2); PG8_BAR;
        PG8_STAGE(PG8_SB(1, 0), cB + kstep, voffB); PG8_STAGE_A(PG8_SA(1, 0), gA + kstep, cA0); PG8_STAGE(PG8_SB(1, 1), cB + hstep + kstep, voffB);
        PG8_WAIT_V(6); PG8_BAR;
    } else {
    PG8_STAGE(PG8_SB(0, 0), cB, voffB); PG8_STAGE_A(PG8_SA(0, 0), gA, cA0); PG8_STAGE(PG8_SB(0, 1), cB + hstep, voffB); PG8_STAGE_A(PG8_SA(0, 1), gA, cA1);
    if (wr == 1) PG8_BAR;
    PG8_WAIT_V(4); PG8_BAR;
    PG8_STAGE(PG8_SB(1, 0), cB + kstep, voffB); PG8_STAGE_A(PG8_SA(1, 0), gA + kstep, cA0); PG8_STAGE(PG8_SB(1, 1), cB + hstep + kstep, voffB);
    PG8_WAIT_V(6); PG8_BAR;
    }
    for (;;) {
        const bool has_next = S.next(ui + 1, nxt);
        const char* nB = has_next ? (const char*)g.Bt + S.b_off(nxt) : cB;
        const unsigned pv = has_next ? S.poll_begin(nxt) : 0u;
        if (has_next) { PG8_AOFFS(nxt, nA0, nA1);
        } else {
#pragma unroll
            for (int i = 0; i < 2; ++i) { nA0[i] = cA0[i]; nA1[i] = cA1[i]; }
        }
        for (int t = 0; t < nt; t += 2) {
            const bool last = (t == nt - 2);
            if constexpr (Epi::MID_T > 0) { if (t == Epi::MID_T) E.mid(acc, cur, wr, wc, fr, fq); }
            if constexpr (Sched::HANDOFF) if (last && has_next) S.poll_end(nxt, pv);
            const char* a1 = gA + (size_t)(t + 1) * kstep;
            const char* a2 = last ? gA : gA + (size_t)(t + 2) * kstep; const char* b2 = last ? nB : cB + (size_t)(t + 2) * kstep;
            const char* a3 = a2 + kstep; const char* b3 = b2 + kstep;
            if constexpr (SP2) {
            PG8_LDB(B0, 0, 0); PG8_LDB(B1, 0, 1); PG8_SCHED; PG8_LDA(At, 0, 0); PG8_STAGE_A(PG8_SA(1, 1), a1, cA1);
            PG8_WAIT_V(8); if constexpr (Sched::HANDOFF) if (t == 2 && pend >= 0) { S.publish(pend); pend = -1; }
            PG8_WAIT_L(0); PG8_BAR; PG8_MMA(0, 0, At, B0); PG8_MMA(0, 1, At, B1); PG8_BAR; PG8_SCHED;
            PG8_LDA(At, 0, 1); PG8_STAGE(PG8_SB(0, 0), b2, voffB); PG8_STAGE(PG8_SB(0, 1), b2 + hstep, voffB); PG8_STAGE_SEL(PG8_SA(0, 0), a2, cA0, nA0);
            PG8_WAIT_V(8); PG8_WAIT_L(0); PG8_BAR; PG8_MMA(1, 0, At, B0); PG8_MMA(1, 1, At, B1); PG8_BAR; PG8_SCHED;
            PG8_LDB(B0, 1, 0); PG8_LDB(B1, 1, 1); PG8_SCHED; PG8_LDA(At, 1, 0); PG8_STAGE_SEL(PG8_SA(0, 1), a2, cA1, nA1);
            PG8_WAIT_V(8); PG8_WAIT_L(0); PG8_BAR; PG8_MMA(0, 0, At, B0); PG8_MMA(0, 1, At, B1); PG8_BAR; PG8_SCHED;
            PG8_LDA(At, 1, 1); PG8_STAGE(PG8_SB(1, 0), b3, voffB); PG8_STAGE(PG8_SB(1, 1), b3 + hstep, voffB); PG8_STAGE_SEL(PG8_SA(1, 0), a3, cA0, nA0);
            PG8_WAIT_V(8); PG8_WAIT_L(0); PG8_BAR; PG8_MMA(1, 0, At, B0); PG8_MMA(1, 1, At, B1); PG8_BAR; PG8_SCHED;
            } else {
            PG8_LDB(B0, 0, 0); PG8_SCHED; PG8_LDA(At, 0, 0); PG8_STAGE_A(PG8_SA(1, 1), a1, cA1);
            PG8_WAIT_L(8); PG8_BAR; PG8_WAIT_L(0); PG8_MMA(0, 0, At, B0); PG8_BAR; PG8_SCHED;
            PG8_LDB(B1, 0, 1); PG8_STAGE(PG8_SB(0, 0), b2, voffB);
            PG8_BAR; PG8_WAIT_L(0); PG8_MMA(0, 1, At, B1); PG8_BAR;
            PG8_LDA(At, 0, 1); PG8_STAGE_SEL(PG8_SA(0, 0), a2, cA0, nA0);
            PG8_BAR; PG8_WAIT_L(0); PG8_MMA(1, 0, At, B0); PG8_BAR; PG8_SCHED;
            PG8_STAGE(PG8_SB(0, 1), b2 + hstep, voffB);
            PG8_WAIT_V(6); PG8_BAR; PG8_MMA(1, 1, At, B1); PG8_BAR;
            PG8_LDB(B0, 1, 0); PG8_SCHED; PG8_LDA(At, 1, 0); PG8_STAGE_SEL(PG8_SA(0, 1), a2, cA1, nA1);
            PG8_WAIT_L(8); PG8_BAR; PG8_WAIT_L(0); PG8_MMA(0, 0, At, B0); PG8_BAR; PG8_SCHED;
            PG8_LDB(B1, 1, 1); PG8_STAGE(PG8_SB(1, 0), b3, voffB);
            PG8_BAR; PG8_WAIT_L(0); PG8_MMA(0, 1, At, B1); PG8_BAR;
            PG8_LDA(At, 1, 1); PG8_STAGE_SEL(PG8_SA(1, 0), a3, cA0, nA0);
            PG8_BAR; PG8_WAIT_L(0); PG8_MMA(1, 0, At, B0); PG8_BAR; PG8_SCHED;
            PG8_STAGE(PG8_SB(1, 1), b3 + hstep, voffB);
            PG8_WAIT_V(6); PG8_BAR; PG8_MMA(1, 1, At, B1); PG8_BAR;
            }
        }
        if constexpr (ALIGN_EPI) { if (wr == 0) PG8_BAR; }
        if constexpr (FP8) asm volatile("s_nop 15\n\ts_nop 15" ::: "memory");
        E(acc, cur, wr, wc, fr, fq);
        if constexpr (Sched::HANDOFF) { if (pend >= 0) { PG8_WAIT_V(0); S.publish(pend); } pend = cur.pm; }
        if (!has_next) break;
#pragma unroll
        for (int a = 0; a < 2; ++a)
#pragma unroll
            for (int b = 0; b < 2; ++b)
#pragma unroll
                for (int m = 0; m < 4; ++m)
#pragma unroll
                    for (int n = 0; n < 2; ++n) acc[a][b][m][n] = (f32x4){0.f, 0.f, 0.f, 0.f};
        cur = nxt; cB = nB; ++ui;
#pragma unroll
        for (int i = 0; i < 2; ++i) { cA0[i] = nA0[i]; cA1[i] = nA1[i]; }
        if constexpr (ALIGN_EPI) { if (wr == 1) PG8_BAR; }
    }
    PG8_WAIT_V(0);
    if constexpr (Sched::HANDOFF) S.publish(pend);
    if constexpr (!ALIGN_EPI) { if (wr == 0) PG8_BAR; }
    PG8_BAR;
#undef PG8_SA
#undef PG8_SB
#undef PG8_STAGE
#undef PG8_STAGE_A
#undef PG8_STAGE_SEL
#undef PG8_AOFFS
#undef PG8_LDA
#undef PG8_LDB
#undef PG8_MMA
#undef PG8_WAIT_V
#undef PG8_WAIT_L
#undef PG8_BAR
#undef PG8_SCHED
}
}

#define GAS __attribute__((address_space(1)))
#define LAS __attribute__((address_space(3)))
typedef unsigned short bf16;
typedef pg8::f32x4 f32x4;
typedef pg8::f32x2 f32x2;
typedef pg8::u32x4 u32x4;
typedef pg8::u32x2 u32x2;
typedef pg8::bf16x8 bf16x8;
using pg8::cvt_pk_bf16;

constexpr int SEQ = 8192, DM = 1024, M = 2 * SEQ;
constexpr int INW = 6400, C_K = 768, C_V = 1536, C_XR = 2304, C_GL = 3328, C_GM = 4352;
constexpr int NEXP = 32, DEXP = 512, CAP = 16384, MAXTILES = 160;
constexpr float EPS = 1e-6f;
constexpr int NWAVES = 8;
constexpr int LDS_BYTES = 147456;
constexpr int TAB_OFF = 131072 + 1024;

constexpr size_t MiB = 1u << 20;
constexpr size_t WS_CTL = 0, CTL_ZERO_BYTES = 32 * 1024;
constexpr size_t WS_WIN = 2 * MiB;
constexpr size_t WS_WOUT = 18 * MiB;
constexpr size_t WS_WRT = 15 * MiB + 512 * 1024;
constexpr size_t WS_WGU = 20 * MiB;
constexpr size_t WS_WD = 84 * MiB;
constexpr size_t WS_H = 116 * MiB;
constexpr size_t WS_PROJ = 148 * MiB;
constexpr size_t WS_ACT = WS_PROJ, WS_Y = WS_PROJ + 40 * MiB;
constexpr size_t WS_HL = 348 * MiB;
constexpr size_t WS_WPLA = 103 * MiB;
constexpr size_t WS_CA = 413 * MiB;
constexpr int CAW = 1280;
constexpr size_t WS_X1B = WS_HL;
constexpr size_t WS_MERGED = 52 * MiB;
constexpr size_t WS_PC = 380 * MiB;
constexpr size_t WS_DELTA = 479 * MiB;
constexpr size_t WS_AGG = 412 * MiB;
constexpr size_t WS_ROUTE = 100 * MiB;
constexpr size_t WS_TOK = 101 * MiB;
constexpr size_t WS_OG = 453 * MiB;
constexpr size_t WS_LSE = 477 * MiB;
constexpr size_t WS_END = 512 * MiB;
constexpr int CW_CNT = 64;

__device__ __forceinline__ float bf2f(unsigned short b) { return __uint_as_float(((unsigned)b) << 16); }
__device__ __forceinline__ float bflo(unsigned w) { return __uint_as_float(w << 16); }
__device__ __forceinline__ float bfhi(unsigned w) { return __uint_as_float(w & 0xffff0000u); }
__device__ __forceinline__ unsigned short f2bf(float f) { return (unsigned short)(cvt_pk_bf16(f, 0.f) & 0xffffu); }
__device__ __forceinline__ float wave_sum(float v) {
#pragma unroll
    for (int o = 1; o < 64; o <<= 1) v += __shfl_xor(v, o);
    return v;
}
__device__ __forceinline__ float wave_max(float v) {
#pragma unroll
    for (int o = 1; o < 64; o <<= 1) v = fmaxf(v, __shfl_xor(v, o));
    return v;
}
__device__ __forceinline__ unsigned pk4_fp8(float a, float b, float c, float d) { int w = 0; w = __builtin_amdgcn_cvt_pk_fp8_f32(a, b, w, false); w = __builtin_amdgcn_cvt_pk_fp8_f32(c, d, w, true); return (unsigned)w; }
constexpr float WSCALE = 32.0f, WINV = 1.0f / 32.0f;
__device__ __forceinline__ void lds_barrier() { asm volatile("s_waitcnt lgkmcnt(0)\n\ts_barrier" ::: "memory"); }
__device__ __forceinline__ void st_wt16(void* p, u32x4 v) { asm volatile("global_store_dwordx4 %0, %1, off sc1\n\ts_nop 1" :: "v"(p), "v"(v) : "memory"); }
__device__ __forceinline__ int team_rows64(int c) { const int x = c & 7, off = c >> 3; return 32 * x + 4 * (off & 7) + (off >> 3); }
__device__ __forceinline__ float sigmoid_f(float x) { return __builtin_amdgcn_rcpf(1.0f + __builtin_amdgcn_exp2f(-1.4426950408889634f * x)); }
__device__ __forceinline__ float gelu_tanh_f(float x) { const float u = 0.7978845608028654f * (x + 0.044715f * x * x * x); return x * sigmoid_f(2.0f * u); }

__device__ const unsigned char BUCKET[3][132] = {
 {0,1,2,3,4,5,6,7,8,9,10,11,12,13,14,15,16,16,16,16,16,16,17,17,17,17,17,17,17,17,18,18,18,18,18,18,18,18,18,18,19,19,19,19,19,19,19,19,19,19,19,19,19,19,20,20,20,20,20,20,20,20,20,20,20,20,20,20,20,20,20,20,20,21,21,21,21,21,21,21,21,21,21,21,21,21,21,21,21,21,21,21,21,21,21,21,21,21,21,22,22,22,22,22,22,22,22,22,22,22,22,22,22,22,22,22,22,22,22,22,22,22,22,22,22,22,22,22,22,0,0,0},
 {0,4,8,12,16,16,17,17,18,18,19,19,19,19,20,20,20,20,20,21,21,21,21,21,21,22,22,22,22,22,22,22,22,22,23,23,23,23,23,23,23,23,23,23,23,23,24,24,24,24,24,24,24,24,24,24,24,24,24,24,24,24,25,25,25,25,25,25,25,25,25,25,25,25,25,25,25,25,25,25,25,25,25,26,26,26,26,26,26,26,26,26,26,26,26,26,26,26,26,26,26,26,26,26,26,26,26,26,26,26,26,26,26,27,27,27,27,27,27,27,27,27,27,27,27,27,27,27,27,0,0,0},
 {0,16,18,19,20,21,21,22,22,23,23,23,24,24,24,24,25,25,25,25,25,26,26,26,26,26,26,26,26,27,27,27,27,27,27,27,27,27,27,28,28,28,28,28,28,28,28,28,28,28,28,28,29,29,29,29,29,29,29,29,29,29,29,29,29,29,29,29,29,29,30,30,30,30,30,30,30,30,30,30,30,30,30,30,30,30,30,30,30,30,30,30,30,30,30,31,31,31,31,31,31,31,31,31,31,31,31,31,31,31,31,31,31,31,31,31,31,31,31,31,31,31,31,31,31,31,31,31,31,0,0,0}};

__device__ __forceinline__ u32x4 pair16(u32x2 a, u32x2 b) {
    const auto x = __builtin_amdgcn_permlane16_swap(a.x, b.x, false, false), y = __builtin_amdgcn_permlane16_swap(a.y, b.y, false, false);
    u32x4 r; r.x = x[0]; r.y = y[0]; r.z = x[1]; r.w = y[1]; return r;
}
__device__ __forceinline__ float sig255(float x) { return __builtin_amdgcn_rcpf(__builtin_fmaf(__builtin_amdgcn_exp2f(-1.4426950408889634f * x), 1.0f / 255.0f, 1.0f / 255.0f)); }
__device__ __forceinline__ unsigned pk4_u8(float a, float b, float c, float d) {
    unsigned r = __builtin_amdgcn_cvt_pk_u8_f32(__builtin_rintf(a), 0, 0u); r = __builtin_amdgcn_cvt_pk_u8_f32(__builtin_rintf(b), 1, r);
    r = __builtin_amdgcn_cvt_pk_u8_f32(__builtin_rintf(c), 2, r); return __builtin_amdgcn_cvt_pk_u8_f32(__builtin_rintf(d), 3, r);
}
__device__ __forceinline__ float ub0(unsigned w) { return (float)(w & 0xffu); }
__device__ __forceinline__ float ub1(unsigned w) { return (float)((w >> 8) & 0xffu); }
__device__ __forceinline__ float ub2(unsigned w) { return (float)((w >> 16) & 0xffu); }
__device__ __forceinline__ float ub3(unsigned w) { return (float)(w >> 24); }
struct EpiProj {
    static constexpr bool PERM = true; static constexpr int MID_T = 0;
    bf16* O;
    __device__ __forceinline__ void operator()(const f32x4 (&acc)[2][2][4][2], const pg8::Unit& u, int wr, int wc, int fr, int fq) const {
        const int row0 = u.pm * 256 + wr * 64 + fr, col0 = u.pn * 256 + wc * 32 + 8 * fq;
        const int mode = u.pn < 3 ? 0 : (u.pn < 17 ? 1 : 3);
        if (mode == 3) {
            const int rowq = row0 + (fq & 1) * 16, cq = (u.pn - 17) * 256 + wc * 32 + 8 * (fq & 2);
#pragma unroll
            for (int ai = 0; ai < 2; ++ai)
#pragma unroll
                for (int mp = 0; mp < 2; ++mp) { unsigned char* rowp = (unsigned char*)(O + (size_t)(rowq + ai * 128 + mp * 32) * INW + C_GM) + cq;
#pragma unroll
                    for (int bj = 0; bj < 2; ++bj) { u32x2 w[2];
#pragma unroll
                        for (int mm = 0; mm < 2; ++mm) { const f32x4 v0 = acc[ai][bj][2 * mp + mm][0], v1 = acc[ai][bj][2 * mp + mm][1];
                            w[mm].x = pk4_u8(sig255(v0[0]), sig255(v0[1]), sig255(v0[2]), sig255(v0[3])); w[mm].y = pk4_u8(sig255(v1[0]), sig255(v1[1]), sig255(v1[2]), sig255(v1[3])); }
                        *(u32x4*)(rowp + bj * 128) = pair16(w[0], w[1]); } }
            return; }
#pragma unroll
        for (int ai = 0; ai < 2; ++ai)
#pragma unroll
            for (int m = 0; m < 4; ++m) { bf16* rowp = O + (size_t)(row0 + ai * 128 + m * 16) * INW + col0;
#pragma unroll
                for (int bj = 0; bj < 2; ++bj) { f32x4 v0 = acc[ai][bj][m][0], v1 = acc[ai][bj][m][1];
                    if (mode == 0) { v0 = v0 * 0.125f; v1 = v1 * 0.125f; }
                    else if (mode == 2) {
#pragma unroll
                        for (int j = 0; j < 4; ++j) { v0[j] = gelu_tanh_f(v0[j]); v1[j] = gelu_tanh_f(v1[j]); } }
                    u32x4 w; w.x = cvt_pk_bf16(v0[0], v0[1]); w.y = cvt_pk_bf16(v0[2], v0[3]); w.z = cvt_pk_bf16(v1[0], v1[1]); w.w = cvt_pk_bf16(v1[2], v1[3]);
                    *(u32x4*)(rowp + bj * 128) = w; } }
    }
};
template <bool HAS_ADD> struct EpiGate {
    static constexpr bool PERM = true; static constexpr int MID_T = 0;
    bf16* O; const bf16* PROJ; const bf16* ADD; int gcol0, pad;
    __device__ __forceinline__ void operator()(const f32x4 (&acc)[2][2][4][2], const pg8::Unit& u, int wr, int wc, int fr, int fq) const {
        const int row0 = u.pm * 256 + wr * 64 + fr, col0 = u.pn * 256 + wc * 32 + 8 * fq;
#pragma unroll
        for (int ai = 0; ai < 2; ++ai) {
            u32x4 gv[4][2], av[4][2];
#pragma unroll
            for (int m = 0; m < 4; ++m)
#pragma unroll
                for (int bj = 0; bj < 2; ++bj) { const size_t r = (size_t)(row0 + ai * 128 + m * 16); const int c = col0 + bj * 128;
                    gv[m][bj] = *(const u32x4*)(PROJ + r * INW + gcol0 + c); if (HAS_ADD) av[m][bj] = *(const u32x4*)(ADD + r * DM + c); }
#pragma unroll
            for (int m = 0; m < 4; ++m)
#pragma unroll
                for (int bj = 0; bj < 2; ++bj) { const size_t r = (size_t)(row0 + ai * 128 + m * 16); const int c = col0 + bj * 128; const u32x4 g = gv[m][bj];
                    f32x4 v0 = acc[ai][bj][m][0], v1 = acc[ai][bj][m][1];
                    v0[0] *= bflo(g.x); v0[1] *= bfhi(g.x); v0[2] *= bflo(g.y); v0[3] *= bfhi(g.y);
                    v1[0] *= bflo(g.z); v1[1] *= bfhi(g.z); v1[2] *= bflo(g.w); v1[3] *= bfhi(g.w);
                    if (HAS_ADD) { const u32x4 a = av[m][bj];
                        v0[0] += bflo(a.x); v0[1] += bfhi(a.x); v0[2] += bflo(a.y); v0[3] += bfhi(a.y);
                        v1[0] += bflo(a.z); v1[1] += bfhi(a.z); v1[2] += bflo(a.w); v1[3] += bfhi(a.w); }
                    u32x4 w; w.x = cvt_pk_bf16(v0[0], v0[1]); w.y = cvt_pk_bf16(v0[2], v0[3]); w.z = cvt_pk_bf16(v1[0], v1[1]); w.w = cvt_pk_bf16(v1[2], v1[3]);
                    *(u32x4*)(O + r * DM + c) = w; }
        }
    }
};
struct EpiGateMid {
    static constexpr bool PERM = true; static constexpr int MID_T = 16;
    bf16* O; const bf16* PROJ; int gcolA, gcolL;
    __device__ __forceinline__ void mid(f32x4 (&acc)[2][2][4][2], const pg8::Unit& u, int wr, int wc, int fr, int fq) const {
        int opq = 0; asm volatile("" : "+v"(opq));
        const int row0 = u.pm * 256 + wr * 64 + fr + opq, col0 = u.pn * 256 + wc * 32 + 8 * fq;
#pragma unroll
        for (int ai = 0; ai < 2; ++ai) {
            u32x2 av[4][2], lv[4][2];
#pragma unroll
            for (int m = 0; m < 4; ++m)
#pragma unroll
                for (int bj = 0; bj < 2; ++bj) { const unsigned char* gp = (const unsigned char*)(PROJ + (size_t)(row0 + ai * 128 + m * 16) * INW + C_GM) + col0 + bj * 128; av[m][bj] = *(const u32x2*)(gp + gcolA); lv[m][bj] = *(const u32x2*)(gp + gcolL); }
#pragma unroll
            for (int m = 0; m < 4; ++m)
#pragma unroll
                for (int bj = 0; bj < 2; ++bj) { const u32x2 a = av[m][bj], l = lv[m][bj];
#define GQ(L, A) ((L) * __builtin_amdgcn_rcpf(fmaxf((A), 1e-28f)))
                    acc[ai][bj][m][0][0] *= GQ(ub0(l.x), ub0(a.x)); acc[ai][bj][m][0][1] *= GQ(ub1(l.x), ub1(a.x)); acc[ai][bj][m][0][2] *= GQ(ub2(l.x), ub2(a.x)); acc[ai][bj][m][0][3] *= GQ(ub3(l.x), ub3(a.x));
                    acc[ai][bj][m][1][0] *= GQ(ub0(l.y), ub0(a.y)); acc[ai][bj][m][1][1] *= GQ(ub1(l.y), ub1(a.y)); acc[ai][bj][m][1][2] *= GQ(ub2(l.y), ub2(a.y)); acc[ai][bj][m][1][3] *= GQ(ub3(l.y), ub3(a.y));
#undef GQ
                }
            asm volatile("" ::: "memory");
        }
    }
    __device__ __forceinline__ void operator()(const f32x4 (&acc)[2][2][4][2], const pg8::Unit& u, int wr, int wc, int fr, int fq) const {
        const int row0 = u.pm * 256 + wr * 64 + fr, col0 = u.pn * 256 + wc * 32 + 8 * fq;
        constexpr float S = 1.0f / 255.0f;
#pragma unroll
        for (int ai = 0; ai < 2; ++ai) {
            u32x2 gv[4][2];
#pragma unroll
            for (int m = 0; m < 4; ++m)
#pragma unroll
                for (int bj = 0; bj < 2; ++bj) gv[m][bj] = *(const u32x2*)((const unsigned char*)(PROJ + (size_t)(row0 + ai * 128 + m * 16) * INW + C_GM) + gcolA + col0 + bj * 128);
#pragma unroll
            for (int m = 0; m < 4; ++m)
#pragma unroll
                for (int bj = 0; bj < 2; ++bj) { const size_t r = (size_t)(row0 + ai * 128 + m * 16); const int c = col0 + bj * 128; const u32x2 g = gv[m][bj];
                    f32x4 v0 = acc[ai][bj][m][0], v1 = acc[ai][bj][m][1];
                    v0[0] *= fmaxf(ub0(g.x), 1e-28f) * S; v0[1] *= fmaxf(ub1(g.x), 1e-28f) * S; v0[2] *= fmaxf(ub2(g.x), 1e-28f) * S; v0[3] *= fmaxf(ub3(g.x), 1e-28f) * S;
                    v1[0] *= fmaxf(ub0(g.y), 1e-28f) * S; v1[1] *= fmaxf(ub1(g.y), 1e-28f) * S; v1[2] *= fmaxf(ub2(g.y), 1e-28f) * S; v1[3] *= fmaxf(ub3(g.y), 1e-28f) * S;
                    u32x4 w; w.x = cvt_pk_bf16(v0[0], v0[1]); w.y = cvt_pk_bf16(v0[2], v0[3]); w.z = cvt_pk_bf16(v1[0], v1[1]); w.w = cvt_pk_bf16(v1[2], v1[3]);
                    st_wt16(O + r * DM + c, w); }
        }
    }
};
struct EpiSwiglu {
    static constexpr bool PERM = true; static constexpr int MID_T = 0;
    unsigned char* O;
    __device__ __forceinline__ void operator()(const f32x4 (&acc)[2][2][4][2], const pg8::Unit& u, int wr, int wc, int fr, int fq) const {
        const int row0 = u.pm * 256 + wr * 64 + fr + (fq & 1) * 16, col0 = u.pn * 128 + wc * 32 + 8 * (fq & 2);
#pragma unroll
        for (int ai = 0; ai < 2; ++ai)
#pragma unroll
            for (int mp = 0; mp < 2; ++mp) { u32x2 w[2];
#pragma unroll
                for (int mm = 0; mm < 2; ++mm) { const int m = 2 * mp + mm; f32x4 v0, v1;
#pragma unroll
                    for (int j = 0; j < 4; ++j) { const float a0 = acc[ai][0][m][0][j], a1 = acc[ai][0][m][1][j];
                        constexpr float IW2 = WSCALE * WSCALE, NL = -WINV * 1.4426950408889634f;
                        v0[j] = a0 * acc[ai][1][m][0][j] * __builtin_amdgcn_rcpf(__builtin_fmaf(__builtin_amdgcn_exp2f(a0 * NL), IW2, IW2));
                        v1[j] = a1 * acc[ai][1][m][1][j] * __builtin_amdgcn_rcpf(__builtin_fmaf(__builtin_amdgcn_exp2f(a1 * NL), IW2, IW2)); }
                    w[mm].x = pk4_fp8(v0[0], v0[1], v0[2], v0[3]); w[mm].y = pk4_fp8(v1[0], v1[1], v1[2], v1[3]); }
                st_wt16(O + (size_t)(row0 + ai * 128 + mp * 32) * DEXP + col0, pair16(w[0], w[1])); }
    }
};
struct EpiPlain {
    static constexpr bool PERM = true; static constexpr int MID_T = 0;
    bf16* O; int ldc; float scale;
    __device__ __forceinline__ void operator()(const f32x4 (&acc)[2][2][4][2], const pg8::Unit& u, int wr, int wc, int fr, int fq) const {
        const int row0 = u.pm * 256 + wr * 64 + fr, col0 = u.pn * 256 + wc * 32 + 8 * fq;
#pragma unroll
        for (int ai = 0; ai < 2; ++ai)
#pragma unroll
            for (int m = 0; m < 4; ++m) { bf16* rowp = O + (size_t)(row0 + ai * 128 + m * 16) * ldc + col0;
#pragma unroll
                for (int bj = 0; bj < 2; ++bj) { const f32x4 v0 = acc[ai][bj][m][0] * scale, v1 = acc[ai][bj][m][1] * scale;
                    u32x4 w; w.x = cvt_pk_bf16(v0[0], v0[1]); w.y = cvt_pk_bf16(v0[2], v0[3]); w.z = cvt_pk_bf16(v1[0], v1[1]); w.w = cvt_pk_bf16(v1[2], v1[3]);
                    st_wt16(rowp + bj * 128, w); } }
    }
};

constexpr float YSCALE = 4.0f, YINV = 0.25f;
struct EpiY8 {
    static constexpr bool PERM = true; static constexpr int MID_T = 0;
    unsigned char* O; float scale;
    __device__ __forceinline__ void operator()(const f32x4 (&acc)[2][2][4][2], const pg8::Unit& u, int wr, int wc, int fr, int fq) const {
        const int row0 = u.pm * 256 + wr * 64 + fr + (fq & 1) * 16, col0 = u.pn * 256 + wc * 32 + 8 * (fq & 2);
#pragma unroll
        for (int ai = 0; ai < 2; ++ai)
#pragma unroll
            for (int mp = 0; mp < 2; ++mp) { unsigned char* rowp = O + (size_t)(row0 + ai * 128 + mp * 32) * DM + col0;
#pragma unroll
                for (int bj = 0; bj < 2; ++bj) { u32x2 w[2];
#pragma unroll
                    for (int mm = 0; mm < 2; ++mm) { const int m = 2 * mp + mm; const f32x4 v0 = acc[ai][bj][m][0] * scale, v1 = acc[ai][bj][m][1] * scale;
                        w[mm].x = pk4_fp8(v0[0], v0[1], v0[2], v0[3]); w[mm].y = pk4_fp8(v1[0], v1[1], v1[2], v1[3]); }
                    *(u32x4*)(rowp + bj * 128) = pair16(w[0], w[1]); }
                asm volatile("" ::: "memory"); }
    }
};

constexpr int XL_OFF = 192;
constexpr int CW_CT = 1024, CW_TMO2 = 960;
template <int MODE> struct MoeOrderT {
    static constexpr int A_AUX = MODE == 1 ? 16 : 0; static constexpr bool HANDOFF = true;
    const LAS int* tab; const int* tok; const unsigned* cnt; unsigned* ctl; int G, c, rb, gather; size_t bstride;
    __device__ __forceinline__ bool next(int i, pg8::Unit& u) const {
        if (i >= 32) return false;
        const int ent = tab[XL_OFF + 32 * MODE + i]; if (ent < 0) return false;
        const int t = ent >> 2, info = tab[1 + t]; u.pm = t; u.pn = ent & 3; u.e = info & 255; u.r0 = info >> 8; return true;
    }
    __device__ __forceinline__ unsigned a_off(const pg8::Unit& u, int r) const {
        if (MODE == 0) { const int n = (int)cnt[u.e]; int idx = u.r0 + r; idx = idx < n ? idx : n - 1; const int t = tok[u.e * CAP + idx]; return (unsigned)t * (unsigned)rb; }
        return (unsigned)(u.pm * 256 + r) * (unsigned)rb;
    }
    __device__ __forceinline__ size_t b_off(const pg8::Unit& u) const { return (size_t)u.e * bstride + (size_t)u.pn * 256 * rb; }
    __device__ __forceinline__ void publish(int pm) const {
        if (MODE == 0) { if ((threadIdx.x & 63) == 0) __hip_atomic_fetch_add(ctl + CW_CT + 16 * pm, 1u, __ATOMIC_RELAXED, __HIP_MEMORY_SCOPE_AGENT); }
    }
    __device__ __forceinline__ unsigned poll_begin(const pg8::Unit& u) const {
        if (MODE == 1) return __hip_atomic_load(ctl + CW_CT + 16 * u.pm, __ATOMIC_RELAXED, __HIP_MEMORY_SCOPE_AGENT);
        return 0u;
    }
    __device__ __forceinline__ void poll_end(const pg8::Unit& u, unsigned v) const {
        if (MODE == 1) { unsigned sp = 0u; v = (unsigned)__builtin_amdgcn_readfirstlane((int)v);
            while (v < 32u) {
                __builtin_amdgcn_s_sleep(2);
                if ((++sp & 255u) == 0u) { if (__hip_atomic_load(ctl + CW_TMO2, __ATOMIC_RELAXED, __HIP_MEMORY_SCOPE_AGENT) != 0u) break;
                    if (sp > (1u << 20)) { __hip_atomic_store(ctl + CW_TMO2, 1u, __ATOMIC_RELAXED, __HIP_MEMORY_SCOPE_AGENT); break; } }
                v = (unsigned)__builtin_amdgcn_readfirstlane((int)__hip_atomic_load(ctl + CW_CT + 16 * u.pm, __ATOMIC_RELAXED, __HIP_MEMORY_SCOPE_AGENT)); }
            asm volatile("" ::: "memory"); }
    }
};
__device__ __forceinline__ void build_moe_table(LAS int* tab, const unsigned* cnt, int tid) {
    if (tid < 64) { const int e = tid; const int n = e < NEXP ? (int)cnt[e] : 0; const int tiles = (n + 255) >> 8; int incl = tiles;
#pragma unroll
        for (int o = 1; o < 32; o <<= 1) { const int v = __shfl_up(incl, o); if (tid >= o) incl += v; }
        const int first = incl - tiles;
        if (e < NEXP) for (int k = 0; k < tiles; ++k) tab[1 + first + k] = e | ((k * 256) << 8);
        { const int x = (int)blockIdx.x & 7, G = (int)gridDim.x, W = (G - x + 7) >> 3, r = (int)blockIdx.x >> 3, mode = tid >> 5, i = tid & 31;
          const int f0 = __shfl(first, x), f1 = __shfl(first, x + 8), f2 = __shfl(first, x + 16), f3 = __shfl(first, x + 24);
          const int n0 = __shfl(tiles, x), n1 = __shfl(tiles, x + 8), n2 = __shfl(tiles, x + 16), n3 = __shfl(tiles, x + 24), nx = 4 * (n0 + n1 + n2 + n3);
          int j = nx;
          if (mode == 0) j = i * W + r;
          else if (nx > 0) {
              const int K = (nx + W - 1) / W, R = nx - (K - 1) * W, nL = R, nS = W - R; const bool mineS = r >= R; const int myidx = mineS ? r - R : r;
              int tL = 3 * K, tS = 3 * (K - 1), done = 0, turn = 0;
              while (done < nx) { const bool pickS = nS > 0 && tS <= tL; const int avail = pickS ? nS : nL, left = nx - done, m = avail < left ? avail : left;
                  if (pickS == mineS) { if (turn == i && myidx < m) j = done + myidx; ++turn; }
                  if (pickS) tS += 2; else tL += 2;
                  done += m; } }
          int ent = -1;
          if (j < nx) { int q = j >> 2, t;
              if (q < n0) t = f0 + q; else { q -= n0; if (q < n1) t = f1 + q; else { q -= n1; if (q < n2) t = f2 + q; else t = f3 + q - n2; } }
              ent = (t << 2) | (j & 3); }
          tab[XL_OFF + tid] = ent; }
        if (e == NEXP - 1) tab[0] = incl; }
}

typedef GAS unsigned gu32;
#define RLX_AGENT __ATOMIC_RELAXED, __HIP_MEMORY_SCOPE_AGENT
#define XB_TMO      128
#define XB_XCNT(j)  (256  + 64 * (j))
#define XB_XSUB(j)  (1280 + 64 * (j))
#define XB_XGEN(j)  (2304 + 64 * (j))
#define XB_TOP      3328
#define XB_TOPGEN   3392
#define XCD_BAR_WORDS 3456
#define XB_SPIN_CAP (1u << 18)
constexpr int CW_BAR_TMO = 4096 + XB_TMO;
__device__ __forceinline__ unsigned xb_ld(unsigned* p)              { return __hip_atomic_load(p, __ATOMIC_RELAXED, __HIP_MEMORY_SCOPE_AGENT); }
__device__ __forceinline__ unsigned xb_add(unsigned* p, unsigned v) { return __hip_atomic_fetch_add(p, v, __ATOMIC_RELAXED, __HIP_MEMORY_SCOPE_AGENT); }
__device__ __forceinline__ unsigned xb_xcc_id() { return (unsigned)__builtin_amdgcn_s_getreg((3 << 11) | 20) & 0xFu; }
#define XB_SPIN(cond, bar) do { unsigned _sp = 0; while (cond) { __builtin_amdgcn_s_sleep(1); \
    if ((++_sp & 255u) == 0u) { if (xb_ld(&(bar)[XB_TMO])) break; if (_sp > XB_SPIN_CAP) { atomicAdd(&(bar)[XB_TMO], 1u); break; } } } } while (0)
struct XcdBarrier { unsigned* bar; unsigned x; volatile LAS unsigned* st; };
__device__ __forceinline__ XcdBarrier xcd_barrier_post(unsigned* bar, volatile LAS unsigned* st) {
    XcdBarrier b; b.bar = bar; b.x = xb_xcc_id(); b.st = st;
    if (threadIdx.x == 0) (void)xb_add(&bar[XB_XCNT(b.x)], 1u);
    return b;
}
__device__ __forceinline__ void xcd_barrier_complete(unsigned* bar, unsigned x, unsigned& nloc, unsigned& nx) {
    const unsigned G = gridDim.x * gridDim.y * gridDim.z;
    unsigned sum, cnt, mine, sp = 0u;
    for (;;) {
        sum = 0u; cnt = 0u; mine = 0u;
#pragma unroll
        for (unsigned j = 0; j < 16; ++j) { const unsigned c = xb_ld(&bar[XB_XCNT(j)]); sum += c; cnt += (c > 0u) ? 1u : 0u; mine = (j == x) ? c : mine; }
        if (sum == G) break;
        __builtin_amdgcn_s_sleep(1);
        if ((++sp & 255u) == 0u) { if (xb_ld(&bar[XB_TMO])) break; if (sp > XB_SPIN_CAP) { atomicAdd(&bar[XB_TMO], 1u); break; } }
    }
    nloc = mine > 0u ? mine : 1u; nx = cnt > 0u ? cnt : 1u;
}
__device__ __forceinline__ void xcd_barrier(const XcdBarrier& b) {
    asm volatile("s_waitcnt vmcnt(0)" ::: "memory");
    __syncthreads();
    if (threadIdx.x == 0) {
        unsigned* bar = b.bar;
        __builtin_amdgcn_s_waitcnt(0);
        unsigned nloc = b.st[0], nx = b.st[1];
        if (nloc == 0u) { xcd_barrier_complete(bar, b.x, nloc, nx); b.st[0] = nloc; b.st[1] = nx; }
        const unsigned old = xb_add(&bar[XB_XSUB(b.x)], 1u);
        const unsigned gen = old / nloc;
        if (old + 1u == (gen + 1u) * nloc) {
            __builtin_amdgcn_fence(__ATOMIC_RELEASE, "agent");
            asm volatile("s_waitcnt vmcnt(0)" ::: "memory");
            const unsigned og = xb_add(&bar[XB_TOP], 1u);
            const unsigned tg = og / nx;
            if (og + 1u == (tg + 1u) * nx) xb_add(&bar[XB_TOPGEN], 1u);
            else XB_SPIN(xb_ld(&bar[XB_TOPGEN]) == tg, bar);
            __builtin_amdgcn_fence(__ATOMIC_ACQUIRE, "agent");
            xb_add(&bar[XB_XGEN(b.x)], 1u);
            asm volatile("s_waitcnt vmcnt(0)" ::: "memory");
        } else {
            XB_SPIN(xb_ld(&bar[XB_XGEN(b.x)]) == gen, bar);
            __builtin_amdgcn_fence(__ATOMIC_ACQUIRE, "agent");
            asm volatile("s_waitcnt vmcnt(0)" ::: "memory");
        }
    }
    __syncthreads();
}

constexpr int CW_TEAM = 128;
__device__ __forceinline__ void team_barrier(unsigned* ctl, unsigned target) {
    asm volatile("s_waitcnt vmcnt(0)" ::: "memory");
    __syncthreads();
    if (threadIdx.x == 0) {
        unsigned* w = ctl + CW_TEAM + 8 * (((int)blockIdx.x & 7) * 8 + (((int)blockIdx.x >> 3) & 7));
        (void)xb_add(w, 1u);
        unsigned sp = 0u;
        while (xb_ld(w) < target) { __builtin_amdgcn_s_sleep(1);
            if ((++sp & 255u) == 0u) { if (xb_ld(ctl + CW_BAR_TMO)) break; if (sp > XB_SPIN_CAP) { atomicAdd(ctl + CW_BAR_TMO, 1u); break; } } }
        __builtin_amdgcn_fence(__ATOMIC_ACQUIRE, "agent");
        asm volatile("s_waitcnt vmcnt(0)" ::: "memory");
    }
    __syncthreads();
}

#ifndef REPEAT_PHASE
#define REPEAT_PHASE -1
#endif
struct P { const float* in[20]; float* out; unsigned char* ws; int ph_lo, ph_hi; };
constexpr int CW_BAR = 4096;
constexpr int MISC_OFF = 131072 + 320;

__device__ __forceinline__ void transpose_item(const float* W, int ldw, bf16* WT, int K, int drow0, int k0, int n0, LAS float* scr, int lane) {
#pragma unroll 8
    for (int i = 0; i < 32; ++i) { const int kk = 2 * i + (lane >> 5); scr[kk * 33 + (lane & 31)] = W[(size_t)(k0 + kk) * ldw + n0 + (lane & 31)]; }
    asm volatile("s_waitcnt lgkmcnt(0)" ::: "memory");
    const int c = lane & 7;
#pragma unroll
    for (int j = 0; j < 4; ++j) { const int n = (lane >> 3) + 8 * j; const LAS float* s = scr + (8 * c) * 33 + n;
        u32x4 o; o.x = cvt_pk_bf16(s[0 * 33], s[1 * 33]); o.y = cvt_pk_bf16(s[2 * 33], s[3 * 33]); o.z = cvt_pk_bf16(s[4 * 33], s[5 * 33]); o.w = cvt_pk_bf16(s[6 * 33], s[7 * 33]);
        *(u32x4*)(WT + (size_t)(drow0 + n) * K + k0 + 8 * c) = o; }
    asm volatile("s_waitcnt lgkmcnt(0)" ::: "memory");
}
struct TItem { const float* W; unsigned char* WT; int K, drow0, k0, n0; };
__device__ __forceinline__ void moe_item(const P& p, int it, TItem& t) {
    unsigned char* ws = p.ws;
    if (it < 32 * 512) { const int e = it >> 9, q = it & 511, kb = q >> 5, nb = q & 31, n0 = 32 * nb, j = n0 & 511, isu = n0 >> 9;
        t.W = p.in[17] + (size_t)e * 1024 * 1024; t.WT = ws + WS_WGU + (size_t)e * 1024 * 1024; t.K = 1024; t.drow0 = 256 * (j >> 7) + 128 * isu + (j & 127); t.k0 = 64 * kb; t.n0 = n0; }
    else { const int r = it - 32 * 512, e = r >> 8, q = r & 255, kb = q >> 5, nb = q & 31;
        t.W = p.in[18] + (size_t)e * 512 * 1024; t.WT = ws + WS_WD + (size_t)e * 1024 * 512; t.K = 512; t.drow0 = 32 * nb; t.k0 = 64 * kb; t.n0 = 32 * nb; }
}
constexpr int N_MOE_ITEMS = 32 * 512 + 32 * 256;
#ifndef MOE_DEPTH
#define MOE_DEPTH 6
#endif
#ifndef MOE_ITEMS_A
#define MOE_ITEMS_A 14848
#endif
#ifndef MOE_ITEMS_B
#define MOE_ITEMS_B 20480
#endif
__device__ __forceinline__ void moe_item_load(const TItem& t, f32x4 (&r)[8], int lane) {
    const float* src = t.W + (size_t)(t.k0 + (lane >> 3)) * 1024 + t.n0 + (lane & 7) * 4;
#pragma unroll
    for (int i = 0; i < 8; ++i) r[i] = __builtin_nontemporal_load((const f32x4*)(src + (size_t)i * 8 * 1024));
}
__device__ __forceinline__ void moe_item_store(const TItem& t, const f32x4 (&r)[8], LAS float* scr, int lane) {
#pragma unroll
    for (int i = 0; i < 8; ++i) { LAS float* d = scr + ((lane >> 3) + 8 * i) * 33 + (lane & 7) * 4; d[0] = r[i].x; d[1] = r[i].y; d[2] = r[i].z; d[3] = r[i].w; }
    asm volatile("s_waitcnt lgkmcnt(0)" ::: "memory");
    const int c = lane & 7;
#pragma unroll
    for (int j = 0; j < 4; ++j) { const int n = (lane >> 3) + 8 * j; const LAS float* s = scr + (8 * c) * 33 + n;
        u32x2 o; o.x = pk4_fp8(s[0 * 33] * WSCALE, s[1 * 33] * WSCALE, s[2 * 33] * WSCALE, s[3 * 33] * WSCALE); o.y = pk4_fp8(s[4 * 33] * WSCALE, s[5 * 33] * WSCALE, s[6 * 33] * WSCALE, s[7 * 33] * WSCALE);
        __builtin_nontemporal_store(o, (u32x2*)(t.WT + (size_t)(t.drow0 + n) * t.K + t.k0 + 8 * c)); }
    asm volatile("s_waitcnt lgkmcnt(0)" ::: "memory");
}
__device__ __forceinline__ void ph_moe_convert(const P& p, LAS unsigned char* lds, int first, int last, int wv, int nwv, int wave, int lane) {
    LAS float* scr = (LAS float*)(lds + wave * 16384);
    constexpr int D = MOE_DEPTH;
    TItem t[D]; f32x4 r[D][8]; int idx[D];
    const int N_MOE_ITEMS = last;
#pragma unroll
    for (int j = 0; j < D; ++j) { idx[j] = first + wv + j * nwv; t[j].W = nullptr; t[j].WT = nullptr; t[j].K = 0; t[j].drow0 = 0; t[j].k0 = 0; t[j].n0 = 0; if (idx[j] < N_MOE_ITEMS) { moe_item(p, idx[j], t[j]); moe_item_load(t[j], r[j], lane); } }
    for (;;) {
        if (idx[0] >= N_MOE_ITEMS) break;
#pragma unroll
        for (int j = 0; j < D; ++j) { if (idx[j] < N_MOE_ITEMS) { moe_item_store(t[j], r[j], scr, lane); idx[j] += D * nwv; if (idx[j] < N_MOE_ITEMS) { moe_item(p, idx[j], t[j]); moe_item_load(t[j], r[j], lane); } } }
    }
}
__device__ __forceinline__ void rms_rows4_to_bf16(const float* x, const float* gain, bf16* o, int row0, int lane) {
    f32x4 v[4][4]; float s[4];
#pragma unroll
    for (int q = 0; q < 4; ++q) { const f32x4* xr = (const f32x4*)(x + (size_t)(row0 + q) * DM) + lane;
#pragma unroll
        for (int j = 0; j < 4; ++j) v[q][j] = xr[64 * j]; }
#pragma unroll
    for (int q = 0; q < 4; ++q) { s[q] = 0.f;
#pragma unroll
        for (int j = 0; j < 4; ++j) s[q] += (v[q][j].x * v[q][j].x + v[q][j].y * v[q][j].y) + (v[q][j].z * v[q][j].z + v[q][j].w * v[q][j].w); }
#pragma unroll
    for (int o_ = 1; o_ < 64; o_ <<= 1) { s[0] += __shfl_xor(s[0], o_); s[1] += __shfl_xor(s[1], o_); s[2] += __shfl_xor(s[2], o_); s[3] += __shfl_xor(s[3], o_); }
    const f32x4* gr = (const f32x4*)gain + lane;
#pragma unroll
    for (int q = 0; q < 4; ++q) { const float rinv = 1.0f / sqrtf(s[q] * (1.f / DM) + EPS); u32x2* o8 = (u32x2*)(o + (size_t)(row0 + q) * DM) + lane;
#pragma unroll
        for (int j = 0; j < 4; ++j) { const f32x4 g = gr[64 * j]; u32x2 w; w.x = cvt_pk_bf16(v[q][j].x * rinv * g.x, v[q][j].y * rinv * g.y); w.y = cvt_pk_bf16(v[q][j].z * rinv * g.z, v[q][j].w * rinv * g.w); o8[64 * j] = w; } }
}
__device__ __forceinline__ void ph_prologue(const P& p, LAS unsigned char* lds, int gw, int NGW, int wave, int lane) {
    LAS float* scr = (LAS float*)(lds + wave * 16384);
    unsigned char* ws = p.ws;
    constexpr int I_IN = 16 * 200, I_PA = 4 * 32, I_PL = 16 * 32, I_OUT = 16 * 32;
    constexpr int NITEMS = I_IN + I_PA + I_PL + I_OUT;
    for (int it = gw; it < NITEMS; it += NGW) {
        int r = it;
        if (r < I_IN) { const int kb = r / 200, nb = r % 200; transpose_item(p.in[3], INW, (bf16*)(ws + WS_WIN), 1024, 32 * nb, 64 * kb, 32 * nb, scr, lane); continue; } r -= I_IN;
        if (r < I_PA) { const int kb = r / 32, nb = r % 32; transpose_item(p.in[11], 1024, (bf16*)(ws + WS_WPLA) + 1024, CAW, 32 * nb, 64 * kb, 32 * nb, scr, lane); continue; } r -= I_PA;
        if (r < I_PL) { const int kb = r / 32, nb = r % 32; transpose_item(p.in[12], 1024, (bf16*)(ws + WS_WPLA), CAW, 32 * nb, 64 * kb, 32 * nb, scr, lane); continue; } r -= I_PL;
        { const int kb = r / 32, nb = r % 32; transpose_item(p.in[13], 1024, (bf16*)(ws + WS_WOUT), 1024, 32 * nb, 64 * kb, 32 * nb, scr, lane); }
    }
    for (int m = gw * 4; m < M; m += NGW * 4) rms_rows4_to_bf16(p.in[0], p.in[2], (bf16*)(ws + WS_H), m, lane);
    {
        bf16* WRT = (bf16*)(ws + WS_WRT); const float* g2 = p.in[14]; const float* wg = p.in[15]; const float* we = p.in[16];
        for (int e = gw * 64 + lane; e < 48 * 1024; e += NGW * 64) { const int c = e >> 10, k = e & 1023; float v = 0.f;
            if (c < 4) v = wg[k * 4 + c] * g2[k]; else if (c < 36) v = we[k * 32 + (c - 4)] * g2[k];
            const unsigned short hi = f2bf(v); const unsigned short lo = f2bf(v - bf2f(hi)); const int kb = k >> 5, kk = k & 31;
            WRT[((kb * 2 + 0) * 48 + c) * 32 + kk] = hi; WRT[((kb * 2 + 1) * 48 + c) * 32 + kk] = lo; } }
}

typedef short v4i16_t __attribute__((ext_vector_type(4)));
constexpr int AT_KS = 0, AT_KP = 144, AT_VS = 36864, AT_VP = 160, AT_RT = 77824;
constexpr int N_ATT_UNITS = 2 * 3 * 64 * 4;
struct AttStage { u32x4 k[4], v[4]; bf16x8 q[2]; };
__device__ __forceinline__ void att_decode(int U, int& b, int& g, int& h, int& d, int& r, int& nblk) {
    const int hh = U & 3, combo = (U >> 2) & 63, bg = U >> 8; b = bg / 3; g = bg - 3 * b; h = 4 * g + hh; const int dsh = 2 * g; d = 1 << dsh; r = combo >> (6 - dsh); nblk = combo & ((64 >> dsh) - 1);
}
__device__ __forceinline__ void att_load(AttStage& st, const bf16* __restrict__ PROJ, int U, int tid, int w, int fr, int fq) {
    int b, g, h, d, r, nblk; att_decode(U, b, g, h, d, r, nblk);
#pragma unroll
    for (int i = 0; i < 4; ++i) { const int pid = tid + 512 * i, key = pid >> 3, ch = pid & 7; int kpos = 128 * (nblk - 1) + key; kpos = kpos < 0 ? 0 : kpos;
        const bf16* rp = PROJ + (size_t)(b * SEQ + kpos * d + r) * INW + h * 64 + ch * 8;
        st.k[i] = *(const u32x4*)(rp + C_K); st.v[i] = *(const u32x4*)(rp + C_V); }
    const bf16* qp = PROJ + (size_t)(b * SEQ + (128 * nblk + 16 * w + fr) * d + r) * INW + h * 64 + 8 * fq;
    st.q[0] = *(const bf16x8*)qp; st.q[1] = *(const bf16x8*)(qp + 32);
}
__device__ __forceinline__ void ph_attention(const bf16* __restrict__ PROJ, const float* __restrict__ rel_bias, bf16* __restrict__ OG, float* __restrict__ LSE, LAS unsigned char* lds, int c, int G, int tid) {
    const int lane = tid & 63, w = __builtin_amdgcn_readfirstlane(tid >> 6), fr = lane & 15, fq = lane >> 4;
    LAS unsigned char* KS = lds + AT_KS; LAS unsigned char* VS = lds + AT_VS; LAS float* RTB = (LAS float*)(lds + AT_RT);
    int U = c; if (U >= N_ATT_UNITS) return;
    lds_barrier();
    for (int e = tid; e < 12 * 160; e += 512) { const int hd = e / 160, x = e - hd * 160, u = x + 112; RTB[e] = (u >= 128 && u <= 256) ? rel_bias[(int)BUCKET[hd >> 2][256 - u] * 12 + hd] : -1e30f; }
    AttStage st; att_load(st, PROJ, U, tid, w, fr, fq);
    for (; U < N_ATT_UNITS; U += G) {
        int b, g, h, d, r, nblk; att_decode(U, b, g, h, d, r, nblk);
        __syncthreads();
#pragma unroll
        for (int i = 0; i < 4; ++i) { const int pid = tid + 512 * i, key = pid >> 3, ch = pid & 7;
            *(LAS u32x4*)(KS + key * AT_KP + ch * 16) = st.k[i]; *(LAS u32x4*)(VS + key * AT_VP + ch * 16) = st.v[i]; }
        const bf16x8 q0 = st.q[0], q1 = st.q[1]; const LAS float* RT = RTB + h * 160;
        __syncthreads();
        if (U + G < N_ATT_UNITS) att_load(st, PROJ, U + G, tid, w, fr, fq);
        f32x4 sc[9];
#pragma unroll
        for (int tt = 0; tt < 9; ++tt) { const LAS unsigned char* kp = KS + (16 * (w + tt) + fr) * AT_KP + fq * 16;
            f32x4 acc = (f32x4){0.f, 0.f, 0.f, 0.f};
            acc = __builtin_amdgcn_mfma_f32_16x16x32_bf16(*(const LAS bf16x8*)kp, q0, acc, 0, 0, 0);
            acc = __builtin_amdgcn_mfma_f32_16x16x32_bf16(*(const LAS bf16x8*)(kp + 64), q1, acc, 0, 0, 0);
            sc[tt] = acc; }
        float mx = -3.0e38f;
#pragma unroll
        for (int tt = 0; tt < 9; ++tt)
#pragma unroll
            for (int i = 0; i < 4; ++i) { float v = sc[tt][i] + RT[16 * tt + 4 * fq + i - fr + 16];
                if (nblk == 0 && (w + tt) < 8) v = -1e30f;
                sc[tt][i] = v; mx = fmaxf(mx, v); }
        mx = fmaxf(mx, __shfl_xor(mx, 16)); mx = fmaxf(mx, __shfl_xor(mx, 32));
        float ls = 0.f;
#pragma unroll
        for (int tt = 0; tt < 9; ++tt)
#pragma unroll
            for (int i = 0; i < 4; ++i) { const float pv = __builtin_amdgcn_exp2f((sc[tt][i] - mx) * 1.4426950408889634f); sc[tt][i] = pv; ls += pv; }
        f32x4 od[4];
#pragma unroll
        for (int dt = 0; dt < 4; ++dt) od[dt] = (f32x4){0.f, 0.f, 0.f, 0.f};
        const int vq = (lane & 15) >> 2, vp = lane & 3;
#pragma unroll
        for (int kb = 0; kb < 5; ++kb) { const int T0 = w + 2 * kb, T1 = kb < 4 ? T0 + 1 : T0;
            u32x4 pk; pk.x = cvt_pk_bf16(sc[2 * kb][0], sc[2 * kb][1]); pk.y = cvt_pk_bf16(sc[2 * kb][2], sc[2 * kb][3]);
            if (kb < 4) { pk.z = cvt_pk_bf16(sc[2 * kb + 1][0], sc[2 * kb + 1][1]); pk.w = cvt_pk_bf16(sc[2 * kb + 1][2], sc[2 * kb + 1][3]); } else { pk.z = 0u; pk.w = 0u; }
            const bf16x8 pb = __builtin_bit_cast(bf16x8, pk);
            const LAS unsigned char* v0 = VS + (16 * T0 + 4 * fq + vq) * AT_VP + 8 * vp; const LAS unsigned char* v1 = VS + (16 * T1 + 4 * fq + vq) * AT_VP + 8 * vp;
#pragma unroll
            for (int dt = 0; dt < 4; ++dt) {
                const v4i16_t a0 = __builtin_amdgcn_ds_read_tr16_b64_v4i16((LAS v4i16_t*)(v0 + dt * 32)), a1 = __builtin_amdgcn_ds_read_tr16_b64_v4i16((LAS v4i16_t*)(v1 + dt * 32));
                bf16x8 va; va[0] = a0[0]; va[1] = a0[1]; va[2] = a0[2]; va[3] = a0[3]; va[4] = a1[0]; va[5] = a1[1]; va[6] = a1[2]; va[7] = a1[3];
                od[dt] = __builtin_amdgcn_mfma_f32_16x16x32_bf16(va, pb, od[dt], 0, 0, 0); } }
        ls += __shfl_xor(ls, 16); ls += __shfl_xor(ls, 32);
        const float inv = 1.0f / ls;
        const size_t orow = (size_t)g * M + (size_t)(b * SEQ + (128 * nblk + 16 * w + fr) * d + r);
        bf16* op = OG + orow * 256 + (h & 3) * 64 + 4 * fq;
#pragma unroll
        for (int dt = 0; dt < 4; ++dt) { u32x2 o; o.x = cvt_pk_bf16(od[dt][0] * inv, od[dt][1] * inv); o.y = cvt_pk_bf16(od[dt][2] * inv, od[dt][3] * inv); *(u32x2*)(op + 16 * dt) = o; }
        if (fq == 0) LSE[(size_t)U * 128 + 16 * w + fr] = mx + __logf(ls);
    }
}

constexpr int LR_WT = 0, LR_XCB = 18432, LR_BF = 36864, LR_AF = 71680, LR_AG = 106496, LR_P = 144, LR_FP = 68;
constexpr int N_LRU_UNITS = 2 * 64 * 16;
struct LruX { u32x4 x[2][4]; };
__device__ __forceinline__ void lru_load_x(LruX& X, const bf16* __restrict__ PROJ, int U, int tid) {
    const int h = U & 15, idx = U >> 4, b = idx >> 6, ck = idx & 63, t0 = ck * 128; const size_t row0 = (size_t)b * SEQ + t0;
#pragma unroll
    for (int it = 0; it < 2; ++it) { const int item = tid + 512 * it, tok = item >> 3, cg = item & 7, c0 = 64 * h + 8 * cg;
#pragma unroll
        for (int j = 0; j < 4; ++j) { const int tt = t0 + tok - 3 + j; u32x4 v = (u32x4){0u, 0u, 0u, 0u};
            if (tt >= 0) v = *(const u32x4*)(PROJ + (row0 + tok - 3 + j) * INW + C_XR + c0);
            X.x[it][j] = v; } }
}
__device__ __forceinline__ void ph_lru_local(const bf16* __restrict__ PROJ, const P& p, bf16* __restrict__ HL, bf16* __restrict__ PC, float* __restrict__ AGG, LAS unsigned char* lds, int c, int G, int tid) {
    const float* conv_w = p.in[4]; const float* conv_b = p.in[5]; const float* w_rg = p.in[6]; const float* b_rg = p.in[7]; const float* w_ig = p.in[8]; const float* b_ig = p.in[9]; const float* lam = p.in[10];
    const int lane = tid & 63, w = __builtin_amdgcn_readfirstlane(tid >> 6), fr = lane & 15, fq = lane >> 4;
    LAS unsigned char* WT = lds + LR_WT; LAS unsigned char* XCB = lds + LR_XCB; LAS float* BFl = (LAS float*)(lds + LR_BF); LAS float* AFl = (LAS float*)(lds + LR_AF); LAS float* AG = (LAS float*)(lds + LR_AG);
    int U = c; if (U >= N_LRU_UNITS) return;
    int cur_h = -1;
    float cw[4][8], cb[8], brg[4], big[4], cc[4];
    LruX X; lru_load_x(X, PROJ, U, tid);
    for (; U < N_LRU_UNITS; U += G) {
        const int h = U & 15, idx = U >> 4, b = idx >> 6, ck = idx & 63, t0 = ck * 128; const size_t row0 = (size_t)b * SEQ + t0;
        __syncthreads();
        if (h != cur_h) { cur_h = h;
            for (int e = tid; e < 2 * 64 * 16; e += 512) { const int gate = e >> 10, rem = e & 1023, iin = rem >> 4, j4 = (rem & 15) * 4;
                const f32x4 wv = *(const f32x4*)((gate ? w_ig : w_rg) + (size_t)(h * 64 + iin) * 64 + j4);
                LAS unsigned short* dst = (LAS unsigned short*)(WT + (gate * 64 + j4) * LR_P + iin * 2);
                dst[0] = f2bf(wv.x); dst[LR_P / 2] = f2bf(wv.y); dst[LR_P] = f2bf(wv.z); dst[3 * LR_P / 2] = f2bf(wv.w); }
            { const int c0 = 64 * h + 8 * (tid & 7);
                const f32x4 b0 = *(const f32x4*)(conv_b + c0), b1 = *(const f32x4*)(conv_b + c0 + 4); cb[0] = b0.x; cb[1] = b0.y; cb[2] = b0.z; cb[3] = b0.w; cb[4] = b1.x; cb[5] = b1.y; cb[6] = b1.z; cb[7] = b1.w;
#pragma unroll
                for (int j = 0; j < 4; ++j) { const f32x4 w0 = *(const f32x4*)(conv_w + j * 1024 + c0), w1 = *(const f32x4*)(conv_w + j * 1024 + c0 + 4);
                    cw[j][0] = w0.x; cw[j][1] = w0.y; cw[j][2] = w0.z; cw[j][3] = w0.w; cw[j][4] = w1.x; cw[j][5] = w1.y; cw[j][6] = w1.z; cw[j][7] = w1.w; } }
#pragma unroll
            for (int jt = 0; jt < 4; ++jt) { const int c = 64 * h + 16 * jt + fr; brg[jt] = -1.4426950408889634f * b_rg[c]; big[jt] = -1.4426950408889634f * b_ig[c]; const float nl = -lam[c]; cc[jt] = 8.0f * (nl > 20.f ? nl : log1pf(expf(nl))); } }
#pragma unroll
        for (int it = 0; it < 2; ++it) { const int item = tid + 512 * it, tok = item >> 3, cg = item & 7;
            float xc[8];
#pragma unroll
            for (int q = 0; q < 8; ++q) xc[q] = cb[q];
#pragma unroll
            for (int j = 0; j < 4; ++j) { const u32x4 xv = X.x[it][j];
                xc[0] += cw[j][0] * bflo(xv.x); xc[1] += cw[j][1] * bfhi(xv.x); xc[2] += cw[j][2] * bflo(xv.y); xc[3] += cw[j][3] * bfhi(xv.y);
                xc[4] += cw[j][4] * bflo(xv.z); xc[5] += cw[j][5] * bfhi(xv.z); xc[6] += cw[j][6] * bflo(xv.w); xc[7] += cw[j][7] * bfhi(xv.w); }
            u32x4 pk; pk.x = cvt_pk_bf16(xc[0], xc[1]); pk.y = cvt_pk_bf16(xc[2], xc[3]); pk.z = cvt_pk_bf16(xc[4], xc[5]); pk.w = cvt_pk_bf16(xc[6], xc[7]);
            *(LAS u32x4*)(XCB + tok * LR_P + cg * 16) = pk;
            *(LAS f32x4*)(BFl + tok * LR_FP + cg * 8) = (f32x4){xc[0], xc[1], xc[2], xc[3]}; *(LAS f32x4*)(BFl + tok * LR_FP + cg * 8 + 4) = (f32x4){xc[4], xc[5], xc[6], xc[7]}; }
        __syncthreads();
        if (U + G < N_LRU_UNITS) lru_load_x(X, PROJ, U + G, tid);
        const bf16x8 a0 = *(const LAS bf16x8*)(XCB + (16 * w + fr) * LR_P + fq * 16), a1 = *(const LAS bf16x8*)(XCB + (16 * w + fr) * LR_P + 64 + fq * 16);
#pragma unroll
        for (int jt = 0; jt < 4; ++jt) {
            f32x4 ra = (f32x4){0.f, 0.f, 0.f, 0.f}, ia = (f32x4){0.f, 0.f, 0.f, 0.f};
            const LAS unsigned char* wrp = WT + (16 * jt + fr) * LR_P + fq * 16; const LAS unsigned char* wip = wrp + 64 * LR_P;
            ra = __builtin_amdgcn_mfma_f32_16x16x32_bf16(a0, *(const LAS bf16x8*)wrp, ra, 0, 0, 0); ra = __builtin_amdgcn_mfma_f32_16x16x32_bf16(a1, *(const LAS bf16x8*)(wrp + 64), ra, 0, 0, 0);
            ia = __builtin_amdgcn_mfma_f32_16x16x32_bf16(a0, *(const LAS bf16x8*)wip, ia, 0, 0, 0); ia = __builtin_amdgcn_mfma_f32_16x16x32_bf16(a1, *(const LAS bf16x8*)(wip + 64), ia, 0, 0, 0);
            const int ch = 16 * jt + fr;
#pragma unroll
            for (int i = 0; i < 4; ++i) { const int tok = 16 * w + 4 * fq + i;
                const float rg = __builtin_amdgcn_rcpf(1.0f + __builtin_amdgcn_exp2f(__builtin_fmaf(ra[i], -1.4426950408889634f, brg[jt])));
                const float ig = __builtin_amdgcn_rcpf(1.0f + __builtin_amdgcn_exp2f(__builtin_fmaf(ia[i], -1.4426950408889634f, big[jt])));
                const float x = -cc[jt] * rg, av = __builtin_amdgcn_exp2f(x * 1.4426950408889634f), x2 = x + x;
                const float om = x2 > -0.02f ? -x2 * (1.0f + x2 * (0.5f + x2 * (1.0f / 6.0f))) : 1.0f - av * av;
                const float xcv = BFl[tok * LR_FP + ch];
                AFl[tok * LR_FP + ch] = av; BFl[tok * LR_FP + ch] = __builtin_amdgcn_sqrtf(om) * (ig * xcv); } }
        __syncthreads();
        float Ps[16], hs[16]; { float Pr = 1.f, hr = 0.f;
#pragma unroll
            for (int t = 0; t < 16; ++t) { const float av = AFl[(16 * w + t) * LR_FP + lane], bv = BFl[(16 * w + t) * LR_FP + lane]; Pr *= av; hr = av * hr + bv; Ps[t] = Pr; hs[t] = hr; }
            AG[w * 128 + lane] = Pr; AG[w * 128 + 64 + lane] = hr; }
        __syncthreads();
        float Ain = 1.f, Hin = 0.f;
        for (int k = 0; k < w; ++k) { const float ak = AG[k * 128 + lane], hk = AG[k * 128 + 64 + lane]; Hin = ak * Hin + hk; Ain *= ak; }
        bf16* hlp = HL + (row0 + 16 * w) * DM + 64 * h + lane; unsigned char* pcp = (unsigned char*)PC + (row0 + 16 * w) * DM + 64 * h + lane;
#pragma unroll
        for (int t = 0; t < 16; ++t) { hlp[(size_t)t * DM] = f2bf(hs[t] + Ps[t] * Hin); pcp[(size_t)t * DM] = (unsigned char)__builtin_amdgcn_cvt_pk_u8_f32(__builtin_rintf(Ps[t] * Ain * 255.f), 0, 0u); }
        if (w == 7) { float* ag = AGG + ((size_t)(b * 64 + ck) * 2) * 1024 + 64 * h + lane; ag[0] = Ps[15] * Ain; ag[1024] = hs[15] + Ps[15] * Hin; }
    }
}

__device__ __forceinline__ void ph_fixup(const bf16* __restrict__ HL, const bf16* __restrict__ PC, const float* __restrict__ AGG, const bf16* __restrict__ PROJ, bf16* __restrict__ LRUO,
                                         const bf16* __restrict__ OG, const float* __restrict__ LSE, bf16* __restrict__ ATT, int G, int tid, int do_merge) {
    for (int U0 = (int)blockIdx.x; U0 < 256; U0 += G) { const int U = G == 256 ? team_rows64(U0) : U0;
        const int half = U & 1, idx = U >> 1, b = idx >> 6, ck = idx & 63, c0 = 8 * (tid & 127), rg = tid >> 7;
        float cr[8];
#pragma unroll
        for (int q = 0; q < 8; ++q) cr[q] = 0.f;
#pragma unroll 8
        for (int k = 0; k < ck; ++k) { const float* ap = AGG + ((size_t)(b * 64 + k) * 2) * 1024 + c0; const f32x4 a0 = *(const f32x4*)ap, a1 = *(const f32x4*)(ap + 4), b0 = *(const f32x4*)(ap + 1024), b1 = *(const f32x4*)(ap + 1028);
            cr[0] = a0.x * cr[0] + b0.x; cr[1] = a0.y * cr[1] + b0.y; cr[2] = a0.z * cr[2] + b0.z; cr[3] = a0.w * cr[3] + b0.w; cr[4] = a1.x * cr[4] + b1.x; cr[5] = a1.y * cr[5] + b1.y; cr[6] = a1.z * cr[6] + b1.z; cr[7] = a1.w * cr[7] + b1.w; }
        const size_t row0 = (size_t)b * SEQ + ck * 128 + half * 64 + rg * 16;
#pragma unroll 8
        for (int i = 0; i < 16; ++i) { const size_t r = row0 + i;
            const u32x4 hl = *(const u32x4*)(HL + r * DM + c0), gg = *(const u32x4*)(PROJ + r * INW + C_GL + c0); const u32x2 pc = *(const u32x2*)((const unsigned char*)PC + r * DM + c0);
            u32x4 o;
            constexpr float S = 1.0f / 255.0f;
            o.x = cvt_pk_bf16((bflo(hl.x) + ub0(pc.x) * S * cr[0]) * gelu_tanh_f(bflo(gg.x)), (bfhi(hl.x) + ub1(pc.x) * S * cr[1]) * gelu_tanh_f(bfhi(gg.x)));
            o.y = cvt_pk_bf16((bflo(hl.y) + ub2(pc.x) * S * cr[2]) * gelu_tanh_f(bflo(gg.y)), (bfhi(hl.y) + ub3(pc.x) * S * cr[3]) * gelu_tanh_f(bfhi(gg.y)));
            o.z = cvt_pk_bf16((bflo(hl.z) + ub0(pc.y) * S * cr[4]) * gelu_tanh_f(bflo(gg.z)), (bfhi(hl.z) + ub1(pc.y) * S * cr[5]) * gelu_tanh_f(bfhi(gg.z)));
            o.w = cvt_pk_bf16((bflo(hl.w) + ub2(pc.y) * S * cr[6]) * gelu_tanh_f(bflo(gg.w)), (bfhi(hl.w) + ub3(pc.y) * S * cr[7]) * gelu_tanh_f(bfhi(gg.w)));
            st_wt16(LRUO + r * CAW + c0, o); }
    }
    if (do_merge) for (int it0 = (int)blockIdx.x * 512 + tid; it0 < M * 32; it0 += G * 512) { const int it = G == 256 ? (team_rows64((int)blockIdx.x) * 2048 + (it0 - (int)blockIdx.x * 512) / (G * 512) * 512 + tid) : it0;
        const int row = it >> 5, cg = it & 31, hh = cg >> 3;
        const int bb = row >> 13, tt = row & (SEQ - 1);
        float lv[3];
#pragma unroll
        for (int g = 0; g < 3; ++g) { const int dsh = 2 * g, r = tt & ((1 << dsh) - 1), m = tt >> dsh, nblk = m >> 7, qi = m & 127, combo = r * (64 >> dsh) + nblk;
            lv[g] = LSE[(size_t)((((bb * 3 + g) << 8) | (combo << 2) | hh)) * 128 + qi]; }
        const float l0 = lv[0], l1 = lv[1], l2 = lv[2];
        const float ml = fmaxf(fmaxf(l0, l1), l2); float w0 = __expf(l0 - ml), w1 = __expf(l1 - ml), w2 = __expf(l2 - ml); const float wi = 1.0f / (w0 + w1 + w2); w0 *= wi; w1 *= wi; w2 *= wi;
        const u32x4 o0 = *(const u32x4*)(OG + (size_t)row * 256 + cg * 8), o1 = *(const u32x4*)(OG + ((size_t)M + row) * 256 + cg * 8), o2 = *(const u32x4*)(OG + ((size_t)2 * M + row) * 256 + cg * 8);
        u32x4 o;
        o.x = cvt_pk_bf16(w0 * bflo(o0.x) + w1 * bflo(o1.x) + w2 * bflo(o2.x), w0 * bfhi(o0.x) + w1 * bfhi(o1.x) + w2 * bfhi(o2.x));
        o.y = cvt_pk_bf16(w0 * bflo(o0.y) + w1 * bflo(o1.y) + w2 * bflo(o2.y), w0 * bfhi(o0.y) + w1 * bfhi(o1.y) + w2 * bfhi(o2.y));
        o.z = cvt_pk_bf16(w0 * bflo(o0.z) + w1 * bflo(o1.z) + w2 * bflo(o2.z), w0 * bfhi(o0.z) + w1 * bfhi(o1.z) + w2 * bfhi(o2.z));
        o.w = cvt_pk_bf16(w0 * bflo(o0.w) + w1 * bflo(o1.w) + w2 * bflo(o2.w), w0 * bfhi(o0.w) + w1 * bfhi(o1.w) + w2 * bfhi(o2.w));
        st_wt16(ATT + (size_t)row * CAW + cg * 8, o);
    }
}

constexpr int RT_LG = 0, RT_SS = RT_LG + 2 * 64 * 48 * 4, RT_CNT = RT_SS + 2 * 64 * 4, RT_BASE = RT_CNT + 32 * 4;
__device__ __forceinline__ void ph_router(const float* __restrict__ X1, const bf16* __restrict__ DELTA, bf16* __restrict__ X1B, const P& p, unsigned char* __restrict__ H2, int* __restrict__ ROUTE, int* __restrict__ TOK, unsigned* __restrict__ cnt, LAS unsigned char* lds, int G, int tid) {
    const float* g2 = p.in[14]; const bf16* WRT = (const bf16*)(p.ws + WS_WRT);
    const int lane = tid & 63, w = __builtin_amdgcn_readfirstlane(tid >> 6), fr = lane & 15, fq = lane >> 4, rt = w & 3, kh = w >> 2;
    LAS float* LG = (LAS float*)(lds + RT_LG); LAS float* SS = (LAS float*)(lds + RT_SS); LAS unsigned* LC = (LAS unsigned*)(lds + RT_CNT); LAS unsigned* LB = (LAS unsigned*)(lds + RT_BASE);
    for (int rb0 = (int)blockIdx.x; rb0 < M / 64; rb0 += G) { const int rb = G == 256 ? team_rows64(rb0) : rb0;
        const int row = rb * 64 + 16 * rt + fr; const float* xp = X1 + (size_t)row * DM + kh * 512 + 8 * fq;
        f32x4 xs[16][2];
#pragma unroll
        for (int ks = 0; ks < 16; ++ks) { xs[ks][0] = *(const f32x4*)(xp + 32 * ks); xs[ks][1] = *(const f32x4*)(xp + 32 * ks + 4); }
        { const bf16* dp = DELTA + (size_t)row * DM + kh * 512 + 8 * fq;
#pragma unroll
            for (int ks = 0; ks < 16; ++ks) { const u32x4 d = *(const u32x4*)(dp + 32 * ks);
                xs[ks][0].x += bflo(d.x); xs[ks][0].y += bfhi(d.x); xs[ks][0].z += bflo(d.y); xs[ks][0].w += bfhi(d.y); xs[ks][1].x += bflo(d.z); xs[ks][1].y += bfhi(d.z); xs[ks][1].z += bflo(d.w); xs[ks][1].w += bfhi(d.w); } }
        if (tid < 32) LC[tid] = 0u;
        f32x4 acc[3]; acc[0] = (f32x4){0.f, 0.f, 0.f, 0.f}; acc[1] = acc[0]; acc[2] = acc[0]; float ss = 0.f;
        const bf16* wq = WRT + ((kh * 16) * 96 + fr) * 32 + 8 * fq;
        bf16* xb = X1B + (size_t)row * DM + kh * 512 + 8 * fq;
        bf16x8 bh[2][3], bl[2][3];
#pragma unroll
        for (int ct = 0; ct < 3; ++ct) { bh[0][ct] = *(const bf16x8*)(wq + ct * 16 * 32); bl[0][ct] = *(const bf16x8*)(wq + (48 + ct * 16) * 32); }
#pragma unroll
        for (int ks = 0; ks < 16; ++ks) {
            wq += 96 * 32; asm volatile("" : "+v"(wq) :: "memory");
            if (ks < 15) {
#pragma unroll
                for (int ct = 0; ct < 3; ++ct) { bh[(ks + 1) & 1][ct] = *(const bf16x8*)(wq + ct * 16 * 32); bl[(ks + 1) & 1][ct] = *(const bf16x8*)(wq + (48 + ct * 16) * 32); } }
            const f32x4 x0 = xs[ks][0], x1 = xs[ks][1];
            ss += (x0.x * x0.x + x0.y * x0.y) + (x0.z * x0.z + x0.w * x0.w) + (x1.x * x1.x + x1.y * x1.y) + (x1.z * x1.z + x1.w * x1.w);
            u32x4 hi, lo;
            hi.x = cvt_pk_bf16(x0.x, x0.y); hi.y = cvt_pk_bf16(x0.z, x0.w); hi.z = cvt_pk_bf16(x1.x, x1.y); hi.w = cvt_pk_bf16(x1.z, x1.w);
            lo.x = cvt_pk_bf16(x0.x - bflo(hi.x), x0.y - bfhi(hi.x)); lo.y = cvt_pk_bf16(x0.z - bflo(hi.y), x0.w - bfhi(hi.y));
            lo.z = cvt_pk_bf16(x1.x - bflo(hi.z), x1.y - bfhi(hi.z)); lo.w = cvt_pk_bf16(x1.z - bflo(hi.w), x1.w - bfhi(hi.w));
            *(u32x4*)(xb + 32 * ks) = hi;
            const bf16x8 ah = __builtin_bit_cast(bf16x8, hi), al = __builtin_bit_cast(bf16x8, lo);
#pragma unroll
            for (int ct = 0; ct < 3; ++ct) {
                acc[ct] = __builtin_amdgcn_mfma_f32_16x16x32_bf16(ah, bh[ks & 1][ct], acc[ct], 0, 0, 0);
                acc[ct] = __builtin_amdgcn_mfma_f32_16x16x32_bf16(ah, bl[ks & 1][ct], acc[ct], 0, 0, 0);
                acc[ct] = __builtin_amdgcn_mfma_f32_16x16x32_bf16(al, bh[ks & 1][ct], acc[ct], 0, 0, 0); } }
        ss += __shfl_xor(ss, 16); ss += __shfl_xor(ss, 32);
#pragma unroll
        for (int ct = 0; ct < 3; ++ct)
#pragma unroll
            for (int i = 0; i < 4; ++i) LG[(kh * 64 + 16 * rt + 4 * fq + i) * 48 + 16 * ct + fr] = acc[ct][i];
        if (fq == 0) SS[kh * 64 + 16 * rt + fr] = ss;
        __syncthreads();
        const float rinv = 1.0f / sqrtf((SS[16 * rt + fr] + SS[64 + 16 * rt + fr]) * (1.f / DM) + EPS);
        unsigned char* hp = H2 + (size_t)row * DM + kh * 512 + 8 * fq; const float* gp = g2 + kh * 512 + 8 * fq;
#pragma unroll
        for (int ks = 0; ks < 16; ++ks) { const f32x4 ga = *(const f32x4*)(gp + 32 * ks), gb = *(const f32x4*)(gp + 32 * ks + 4); const f32x4 x0 = xs[ks][0], x1 = xs[ks][1];
            u32x2 o; o.x = pk4_fp8(x0.x * rinv * ga.x, x0.y * rinv * ga.y, x0.z * rinv * ga.z, x0.w * rinv * ga.w); o.y = pk4_fp8(x1.x * rinv * gb.x, x1.y * rinv * gb.y, x1.z * rinv * gb.z, x1.w * rinv * gb.w);
            *(u32x2*)(hp + 32 * ks) = o; asm volatile("" ::: "memory"); }
        if (w == 0) {
            const int r = rb * 64 + lane; const float ri = 1.0f / sqrtf((SS[lane] + SS[64 + lane]) * (1.f / DM) + EPS);
            const LAS float* l0 = LG + lane * 48; const LAS float* l1 = LG + (64 + lane) * 48;
            float lgt[4];
#pragma unroll
            for (int c = 0; c < 4; ++c) lgt[c] = (l0[c] + l1[c]) * ri;
            int gs = 0; float gm = lgt[0];
#pragma unroll
            for (int c = 1; c < 4; ++c) if (lgt[c] > gm) { gm = lgt[c]; gs = c; }
            float den = 0.f;
#pragma unroll
            for (int c = 0; c < 4; ++c) den += expf(lgt[c] - gm);
            const float psel = 1.0f / den;
            float ls[8];
#pragma unroll
            for (int c = 0; c < 8; ++c) ls[c] = (l0[4 + gs * 8 + c] + l1[4 + gs * 8 + c]) * ri;
            int i1 = 0; float v1 = ls[0];
#pragma unroll
            for (int c = 1; c < 8; ++c) if (ls[c] > v1) { v1 = ls[c]; i1 = c; }
            int i2 = -1; float v2 = -3.0e38f;
#pragma unroll
            for (int c = 0; c < 8; ++c) if (c != i1 && ls[c] > v2) { v2 = ls[c]; i2 = c; }
            const float e2 = expf(v2 - v1); const float w1 = psel / (1.f + e2), w2 = psel * e2 / (1.f + e2);
            const int ea = gs * 8 + i1, eb = gs * 8 + i2;
            const unsigned la = __hip_atomic_fetch_add(LC + ea, 1u, __ATOMIC_RELAXED, __HIP_MEMORY_SCOPE_WORKGROUP);
            const unsigned lb = __hip_atomic_fetch_add(LC + eb, 1u, __ATOMIC_RELAXED, __HIP_MEMORY_SCOPE_WORKGROUP);
            asm volatile("s_waitcnt lgkmcnt(0)" ::: "memory");
            if (lane < 32) { const unsigned n = LC[lane]; LB[lane] = n ? atomicAdd(cnt + lane, n) : 0u; }
            asm volatile("s_waitcnt vmcnt(0) lgkmcnt(0)" ::: "memory");
            const int sa = (int)(LB[ea] + la), sb = (int)(LB[eb] + lb);
            __hip_atomic_store(TOK + ea * CAP + sa, r, __ATOMIC_RELAXED, __HIP_MEMORY_SCOPE_AGENT); __hip_atomic_store(TOK + eb * CAP + sb, r, __ATOMIC_RELAXED, __HIP_MEMORY_SCOPE_AGENT);
            int* rr = ROUTE + (size_t)r * 8; rr[0] = ea; rr[1] = eb; rr[2] = sa; rr[3] = sb; ((float*)rr)[4] = w1; ((float*)rr)[5] = w2;
        }
        __syncthreads();
    }
}

__device__ __forceinline__ void ph_final(const bf16* __restrict__ X1B, float* __restrict__ OUT, const unsigned char* __restrict__ Y, const int* __restrict__ ROUTE, const unsigned* __restrict__ cnt, const float* __restrict__ gf, int gw, int NGW, int lane) {
    int tiles = lane < NEXP ? (int)((cnt[lane] + 255u) >> 8) : 0; int incl = tiles;
#pragma unroll
    for (int o = 1; o < 32; o <<= 1) { const int n = __shfl_up(incl, o); if (lane >= o) incl += n; }
    const int cbase = (incl - tiles) * 256;
    f32x4 g[4];
#pragma unroll
    for (int j = 0; j < 4; ++j) g[j] = *((const f32x4*)gf + lane + 64 * j);
    for (int row0 = gw * 4; row0 < M; row0 += NGW * 4) {
        int ea = 0, eb = 0, sa = 0, sb = 0; float w1 = 0.f, w2 = 0.f;
        if (lane < 4) { const int* r = ROUTE + (size_t)(row0 + lane) * 8; const u32x4 a = *(const u32x4*)r; const f32x2 b = *(const f32x2*)(r + 4); ea = (int)a.x; eb = (int)a.y; sa = (int)a.z; sb = (int)a.w; w1 = b.x; w2 = b.y; }
        const int pa = __shfl(cbase, ea) + sa, pb = __shfl(cbase, eb) + sb;
        f32x4 v[4][4]; unsigned ya[4][4], yb[4][4]; u32x2 dl[4][4]; float wa[4], wb[4];
#pragma unroll
        for (int q = 0; q < 4; ++q) { const int qa = __shfl(pa, q), qb = __shfl(pb, q); wa[q] = __shfl(w1, q) * YINV; wb[q] = __shfl(w2, q) * YINV;
            const unsigned* pya = (const unsigned*)(Y + (size_t)qa * DM) + lane; const unsigned* pyb = (const unsigned*)(Y + (size_t)qb * DM) + lane;
#pragma unroll
            for (int j = 0; j < 4; ++j) { ya[q][j] = pya[64 * j]; yb[q][j] = pyb[64 * j]; dl[q][j] = *((const u32x2*)(X1B + (size_t)(row0 + q) * DM) + lane + 64 * j); } }
        float s[4];
#pragma unroll
        for (int q = 0; q < 4; ++q) { s[q] = 0.f;
#pragma unroll
            for (int j = 0; j < 4; ++j) { const u32x2 d = dl[q][j]; f32x4 t; t.x = bflo(d.x); t.y = bfhi(d.x); t.z = bflo(d.y); t.w = bfhi(d.y);
                const f32x2 a0 = __builtin_amdgcn_cvt_pk_f32_fp8((int)ya[q][j], false), a1 = __builtin_amdgcn_cvt_pk_f32_fp8((int)ya[q][j], true), b0 = __builtin_amdgcn_cvt_pk_f32_fp8((int)yb[q][j], false), b1 = __builtin_amdgcn_cvt_pk_f32_fp8((int)yb[q][j], true);
                t.x += wa[q] * a0.x + wb[q] * b0.x; t.y += wa[q] * a0.y + wb[q] * b0.y; t.z += wa[q] * a1.x + wb[q] * b1.x; t.w += wa[q] * a1.y + wb[q] * b1.y;
                v[q][j] = t; s[q] += (t.x * t.x + t.y * t.y) + (t.z * t.z + t.w * t.w); }
            asm volatile("" : "+v"(s[q]) :: "memory"); }
#pragma unroll
        for (int o = 1; o < 64; o <<= 1) { s[0] += __shfl_xor(s[0], o); s[1] += __shfl_xor(s[1], o); s[2] += __shfl_xor(s[2], o); s[3] += __shfl_xor(s[3], o); }
#pragma unroll
        for (int q = 0; q < 4; ++q) { const float rinv = 1.0f / sqrtf(s[q] * (1.f / DM) + EPS); f32x4* xr = (f32x4*)(OUT + (size_t)(row0 + q) * DM) + lane;
#pragma unroll
            for (int j = 0; j < 4; ++j) { f32x4 o; o.x = v[q][j].x * rinv * g[j].x; o.y = v[q][j].y * rinv * g[j].y; o.z = v[q][j].z * rinv * g[j].z; o.w = v[q][j].w * rinv * g[j].w; xr[64 * j] = o; } }
    }
}

constexpr int NPHASE = 9;
__global__ void __launch_bounds__(512, 2) mega_fwd(P p) {
    extern __shared__ __attribute__((aligned(16))) unsigned char lds_raw[];
    LAS unsigned char* lds = (LAS unsigned char*)lds_raw;
    const int G = (int)gridDim.x;
#define IDS() const int tid = fresh_tid(), lane = tid & 63, wave = __builtin_amdgcn_readfirstlane(tid >> 6), gw = (int)blockIdx.x * NWAVES + wave, NGW = G * NWAVES, gt = (int)blockIdx.x * 512 + tid, NGT = G * 512; (void)lane; (void)gw; (void)NGW; (void)gt; (void)NGT
    unsigned char* ws = p.ws;
    gu32* ctl = (gu32*)(ws + WS_CTL);
    { IDS(); for (int u = tid; u < (LDS_BYTES - 131072) / 4; u += 512) ((LAS unsigned*)(lds + 131072))[u] = 0u; }
    __syncthreads();
    volatile LAS unsigned* MISC = (volatile LAS unsigned*)(lds + MISC_OFF);
    XcdBarrier bar = xcd_barrier_post((unsigned*)ctl + CW_BAR, MISC + 8);
    const int lo = p.ph_lo, hi = p.ph_hi;
#define IN(k) (lo <= (k) && (k) < hi)
    bf16* PROJ = (bf16*)(ws + WS_PROJ); bf16* H = (bf16*)(ws + WS_H); unsigned* cnt = (unsigned*)(ws + WS_CTL) + CW_CNT;
    LAS int* tab = (LAS int*)(lds + TAB_OFF);

#define RUN(k, BODY) do { if (IN(k)) { BODY; if (REPEAT_PHASE == (k)) { xcd_barrier(bar); BODY; } } if (IN(k) && IN((k) + 1)) { if (G == 256 && (k) >= 3 && (k) <= 5) team_barrier((unsigned*)ctl, 4u * ((k) - 2)); else xcd_barrier(bar); } } while (0)
#define PHASE_0 { IDS(); ph_prologue(p, lds, gw, NGW, wave, lane); }
#define PHASE_1 { const int NG = G >= 256 ? 229 : G; const int NA = G >= 256 ? MOE_ITEMS_A : 0; const int NB = G >= 256 ? MOE_ITEMS_B : 0;     \
        if ((int)blockIdx.x < NG) { pg8::Gemm g{H, (const bf16*)(ws + WS_WIN), M, INW, 1024, 0}; EpiProj E{PROJ}; pg8::StaticOrder S; S.init(M, INW, 2048, NG, (int)blockIdx.x); \
            pg8::gemm_phase<EpiProj, pg8::StaticOrder, false, true, true>(lds, g, S, E); } \
        else { IDS(); ph_moe_convert(p, lds, 0, NA, ((int)blockIdx.x - NG) * NWAVES + wave, (G - NG) * NWAVES, wave, lane); } \
        { IDS(); ph_moe_convert(p, lds, NB, N_MOE_ITEMS, gw, NGW, wave, lane); } }
#define PHASE_2 { const int NC = G >= 256 ? 224 : G;       \
        if ((int)blockIdx.x < NC) { ph_attention(PROJ, p.in[1], (bf16*)(ws + WS_OG), (float*)(ws + WS_LSE), lds, ((int)blockIdx.x + (NC - 32)) % NC, NC, fresh_tid());     \
            ph_lru_local(PROJ, p, (bf16*)(ws + WS_HL), (bf16*)(ws + WS_PC), (float*)(ws + WS_AGG), lds, (int)blockIdx.x, NC, fresh_tid()); } \
        else { IDS(); ph_moe_convert(p, lds, MOE_ITEMS_A, MOE_ITEMS_B, ((int)blockIdx.x - NC) * NWAVES + wave, (G - NC) * NWAVES, wave, lane); } }
#define PHASE_3 { ph_fixup((const bf16*)(ws + WS_HL), (const bf16*)(ws + WS_PC), (const float*)(ws + WS_AGG), PROJ, (bf16*)(ws + WS_CA), (const bf16*)(ws + WS_OG), (const float*)(ws + WS_LSE), (bf16*)(ws + WS_CA) + 1024, G, fresh_tid(), 1); }
#define PHASE_4 { pg8::Gemm g{(const bf16*)(ws + WS_CA), (const bf16*)(ws + WS_WPLA), M, 1024, CAW, 0}; EpiGateMid E{(bf16*)(ws + WS_MERGED), PROJ, 0, 1024}; pg8::StaticOrder S; S.init(M, 1024, CAW * 2, G, (int)blockIdx.x); \
        pg8::gemm_phase<EpiGateMid, pg8::StaticOrder, false, false, true>(lds, g, S, E); }
#define PHASE_5 { pg8::Gemm g{(const bf16*)(ws + WS_MERGED), (const bf16*)(ws + WS_WOUT), M, 1024, 1024, 0}; EpiPlain E{(bf16*)(ws + WS_DELTA), 1024, 1.0f}; pg8::StaticOrder S; S.init(M, 1024, 2048, G, (int)blockIdx.x); \
        pg8::gemm_phase<EpiPlain, pg8::StaticOrder, false, false, true>(lds, g, S, E); }
#define PHASE_6 { ph_router(p.in[0], (const bf16*)(ws + WS_DELTA), (bf16*)(ws + WS_X1B), p, (unsigned char*)H, (int*)(ws + WS_ROUTE), (int*)(ws + WS_TOK), cnt, lds, G, fresh_tid()); }
#define PHASE_7 { build_moe_table(tab, cnt, fresh_tid()); __syncthreads(); \
        { pg8::Gemm g{H, (const bf16*)(ws + WS_WGU), MAXTILES * 256, 1024, 1024, 0}; EpiSwiglu E{ws + WS_ACT}; \
          MoeOrderT<0> S; S.tab = tab; S.tok = (const int*)(ws + WS_TOK); S.cnt = cnt; S.ctl = (unsigned*)ctl; S.G = G; S.c = (int)blockIdx.x; S.rb = 1024; S.gather = 1; S.bstride = (size_t)1024 * 1024; \
          pg8::gemm_phase<EpiSwiglu, MoeOrderT<0>, true, true, true>(lds, g, S, E); } \
        { pg8::Gemm g{(const bf16*)(ws + WS_ACT), (const bf16*)(ws + WS_WD), MAXTILES * 256, 1024, 512, 0}; EpiY8 E{ws + WS_Y, WINV * YSCALE}; \
          MoeOrderT<1> S; S.tab = tab; S.tok = (const int*)(ws + WS_TOK); S.cnt = cnt; S.ctl = (unsigned*)ctl; S.G = G; S.c = (int)blockIdx.x; S.rb = 512; S.gather = 0; S.bstride = (size_t)1024 * 512; \
          pg8::gemm_phase<EpiY8, MoeOrderT<1>, true, true, true>(lds, g, S, E); } }
#define PHASE_8 { IDS(); ph_final((const bf16*)(ws + WS_X1B), p.out, ws + WS_Y, (const int*)(ws + WS_ROUTE), cnt, p.in[19], gw, NGW, lane); }
    RUN(0, PHASE_0); RUN(1, PHASE_1);
    RUN(2, PHASE_2); RUN(3, PHASE_3); RUN(4, PHASE_4); RUN(5, PHASE_5); RUN(6, PHASE_6); RUN(7, PHASE_7); RUN(8, PHASE_8);
#undef IN
#undef IDS
}

#ifndef MK_PER_PHASE
#define MK_PER_PHASE 0
#endif
extern "C" void kernel_launch(void* const* d_in, const int* in_sizes, int n_in, void* d_out, int out_size, void* d_ws, size_t ws_size, hipStream_t stream) {
    static int grid = 0;
    if (grid == 0) {
        if (n_in != 20 || out_size != M * DM || ws_size < WS_END) { fprintf(stderr, "kernel_launch: unexpected shapes (n_in %d out %d ws %zu)\n", n_in, out_size, ws_size); grid = -1; return; }
        int dev = 0, cus = 0, per_cu = 0; if (hipGetDevice(&dev) != hipSuccess || hipDeviceGetAttribute(&cus, hipDeviceAttributeMultiprocessorCount, dev) != hipSuccess) { grid = -1; return; }
        if (hipFuncSetAttribute((const void*)mega_fwd, hipFuncAttributeMaxDynamicSharedMemorySize, LDS_BYTES) != hipSuccess) { grid = -1; return; }
        if (hipOccupancyMaxActiveBlocksPerMultiprocessor(&per_cu, (const void*)mega_fwd, 512, LDS_BYTES) != hipSuccess || per_cu < 1) { fprintf(stderr, "kernel_launch: occupancy query says %d\n", per_cu); (void)hipGetLastError(); grid = -1; return; }
        grid = cus;
    }
    if (grid < 0) return;
    unsigned char* ws = (unsigned char*)d_ws;
    (void)hipMemsetAsync(ws + WS_CTL, 0, CTL_ZERO_BYTES, stream);
    P p{}; for (int i = 0; i < 20; ++i) p.in[i] = (const float*)d_in[i]; p.out = (float*)d_out; p.ws = ws;
#if MK_PER_PHASE
    for (int k = 0; k < NPHASE; ++k) { p.ph_lo = k; p.ph_hi = k + 1; hipLaunchKernelGGL(mega_fwd, dim3(grid), dim3(512), LDS_BYTES, stream, p); }
#else
    p.ph_lo = 0; p.ph_hi = NPHASE; hipLaunchKernelGGL(mega_fwd, dim3(grid), dim3(512), LDS_BYTES, stream, p);
#endif
}
```

```cpp
#include <hip/hip_runtime.h>
#include <cstdio>
#include <cstdint>

__device__ __forceinline__ int fresh_tid() { int t = (int)threadIdx.x; asm volatile("" : "+v"(t)); return t; }
namespace pg8 {
#define PG8_LAS __attribute__((address_space(3)))
typedef unsigned short bf16_t;
typedef short bf16x8 __attribute__((ext_vector_type(8)));
typedef float f32x4 __attribute__((ext_vector_type(4)));
typedef float f32x2 __attribute__((ext_vector_type(2)));
typedef unsigned u32x4 __attribute__((ext_vector_type(4)));
typedef unsigned u32x2 __attribute__((ext_vector_type(2)));
constexpr int BM = 256, BK = 64, HALF = 128, HTB = HALF * BK * 2  , STAGE_BYTES = 8 * HTB, NXCD = 8, WGM = 8;

__host__ __device__ __forceinline__ int lds_byte(int r, int c) { const int st = (r >> 4) * 2 + (c >> 5), rr = r & 15, cc = c & 31, ob = rr * 64 + cc * 2; return st * 1024 + (ob ^ (((ob >> 9) & 1) << 5)); }
__host__ __device__ __forceinline__ void stage_rc(int b, int& R, int& C) { const int st = b / 1024, sb = b % 1024, swz = sb ^ (((sb >> 9) & 1) << 5); R = (st >> 1) * 16 + swz / 64; C = (st & 1) * 32 + (swz % 64) / 2; }
__host__ __device__ __forceinline__ int perm32(int rho) { const int n = rho >> 4, i = rho & 15; return 8 * (i >> 2) + 4 * n + (i & 3); }

struct Unit { int pm, pn, e, r0, nv; };
struct Gemm { const bf16_t* A; const bf16_t* Bt; int M, N, K, pad; };

struct StaticOrder {
    int nM, nN, nwg, G, c, rb;
    __host__ __device__ void init(int M, int N, int rb_, int G_, int c_) { nM = M / BM; nN = N / BM; nwg = nM * nN; G = G_; c = c_; rb = rb_; }
    __device__ __forceinline__ bool next(int i, Unit& u) const {
        const long L = (long)i * G + c; if (L >= nwg) return false;
        int wgid = (int)L; { const int q = nwg / NXCD, r = nwg % NXCD, xcd = wgid % NXCD, off = wgid / NXCD; wgid = (xcd < r ? xcd * (q + 1) : r * (q + 1) + (xcd - r) * q) + off; }
        const int nig = WGM * nN, gid = wgid / nig, fm = gid * WGM, gsz = (nM - fm) < WGM ? (nM - fm) : WGM;
        u.pm = fm + ((wgid % nig) % gsz); u.pn = (wgid % nig) / gsz; u.e = 0; u.r0 = 0; u.nv = 256; return true;
    }
    __device__ __forceinline__ unsigned a_off(const Unit& u, int r) const { return (unsigned)(u.pm * BM + r) * (unsigned)rb; }
    __device__ __forceinline__ size_t b_off(const Unit& u) const { return (size_t)u.pn * BM * rb; }
    static constexpr int A_AUX = 0; static constexpr bool HANDOFF = false;
    __device__ __forceinline__ unsigned poll_begin(const Unit&) const { return 0u; }
    __device__ __forceinline__ void poll_end(const Unit&, unsigned) const {}
    __device__ __forceinline__ void publish(int) const {}
};

__device__ __forceinline__ unsigned cvt_pk_bf16(float lo, float hi) { unsigned r; asm volatile("v_cvt_pk_bf16_f32 %0, %1, %2" : "=v"(r) : "v"(lo), "v"(hi)); return r; }

typedef int i32x8 __attribute__((ext_vector_type(8)));
template <class Epi, class Sched, bool FP8 = false, bool ALIGN_EPI = false, bool SP2 = false>
__device__ __forceinline__ void gemm_phase(PG8_LAS unsigned char* lds, const Gemm g, const Sched& S, const Epi& E) {
    const int tid = fresh_tid(), wid = __builtin_amdgcn_readfirstlane(tid >> 6), lane = tid & 63, wr = wid >> 2, wc = wid & 3, fr = lane & 15, fq = lane >> 4;
    const int RB = FP8 ? g.K : g.K * 2, nt = RB / (BK * 2);
    unsigned voffB[2];
#pragma unroll
    for (int i = 0; i < 2; ++i) { int R, C; stage_rc(tid * 16 + i * 8192, R, C); const int Rb = Epi::PERM ? ((R & ~31) + perm32(R & 31)) : R;
        voffB[i] = (unsigned)(Rb * RB + C * 2); }
#define PG8_AOFFS(U, A0, A1) do { const int _t = fresh_tid(); _Pragma("unroll") for (int i = 0; i < 2; ++i) { int R, C; stage_rc(_t * 16 + i * 8192, R, C); A0[i] = S.a_off(U, R) + (unsigned)C * 2u; A1[i] = S.a_off(U, HALF + R) + (unsigned)C * 2u; } } while (0)
    const size_t kstep = (size_t)(BK * 2);
    const size_t hstep = (size_t)HALF * RB;
    const unsigned ldsw = (unsigned)wid * 1024u;
    const int aoff = lds_byte(wr * 64 + fr, fq * 8), boff = lds_byte(wc * 32 + fr, fq * 8);
    const int aoff8 = lds_byte(wr * 64 + fr, fq * 16), boff8 = lds_byte(wc * 32 + fr, fq * 16);
#define PG8_SA(b, h) (((b) * 2 + (h)) * HTB)
#define PG8_SB(b, h) ((4 + (b) * 2 + (h)) * HTB)
#define PG8_STAGE(bufoff, gbase, voff) do { _Pragma("unroll") for (int _i = 0; _i < 2; ++_i) \
        __builtin_amdgcn_global_load_lds((const unsigned*)((const char*)(gbase) + (voff)[_i]), (PG8_LAS unsigned*)(lds + (bufoff) + ldsw + _i * 8192), 16, 0, 0); } while (0)
#define PG8_STAGE_A(bufoff, gbase, voff) do { _Pragma("unroll") for (int _i = 0; _i < 2; ++_i) \
        __builtin_amdgcn_global_load_lds((const unsigned*)((const char*)(gbase) + (voff)[_i]), (PG8_LAS unsigned*)(lds + (bufoff) + ldsw + _i * 8192), 16, 0, Sched::A_AUX); } while (0)
#define PG8_LDA(dst, b, h) do { if constexpr (FP8) { _Pragma("unroll") for (int m = 0; m < 4; ++m) dst##8[m] = *(const PG8_LAS i32x8*)(lds + PG8_SA(b, h) + aoff8 + m * 2048); } \
        else { _Pragma("unroll") for (int m = 0; m < 4; ++m) _Pragma("unroll") for (int k = 0; k < 2; ++k) dst[m][k] = *(const PG8_LAS bf16x8*)(lds + PG8_SA(b, h) + aoff + m * 2048 + k * 1024); } } while (0)
#define PG8_LDB(dst, b, h) do { if constexpr (FP8) { _Pragma("unroll") for (int n = 0; n < 2; ++n) dst##8[n] = *(const PG8_LAS i32x8*)(lds + PG8_SB(b, h) + boff8 + n * 2048); } \
        else { _Pragma("unroll") for (int n = 0; n < 2; ++n) _Pragma("unroll") for (int k = 0; k < 2; ++k) dst[n][k] = *(const PG8_LAS bf16x8*)(lds + PG8_SB(b, h) + boff + n * 2048 + k * 1024); } } while (0)
#define PG8_MMA(ai, bj, At, Bt) do { __builtin_amdgcn_s_setprio(1); if constexpr (FP8) { _Pragma("unroll") for (int m = 0; m < 4; ++m) _Pragma("unroll") for (int n = 0; n < 2; ++n) \
            asm volatile("v_mfma_f32_16x16x128_f8f6f4 %0, %1, %2, %0" : "+v"(acc[ai][bj][m][n]) : "v"(Bt##8[n]), "v"(At##8[m]));     } \
        else { _Pragma("unroll") for (int m = 0; m < 4; ++m) _Pragma("unroll") for (int n = 0; n < 2; ++n) _Pragma("unroll") for (int k = 0; k < 2; ++k) \
            acc[ai][bj][m][n] = __builtin_amdgcn_mfma_f32_16x16x32_bf16(Bt[n][k], At[m][k], acc[ai][bj][m][n], 0, 0, 0); } __builtin_amdgcn_s_setprio(0); } while (0)
#define PG8_STAGE_SEL(bufoff, gbase, va, vb) do { _Pragma("unroll") for (int _i = 0; _i < 2; ++_i) \
        __builtin_amdgcn_global_load_lds((const unsigned*)((const char*)(gbase) + (last ? (vb)[_i] : (va)[_i])), (PG8_LAS unsigned*)(lds + (bufoff) + ldsw + _i * 8192), 16, 0, Sched::A_AUX); } while (0)
#define PG8_WAIT_V(n) asm volatile("s_waitcnt vmcnt(" #n ")" ::: "memory")
#define PG8_WAIT_L(n) asm volatile("s_waitcnt lgkmcnt(" #n ")" ::: "memory")
#define PG8_BAR __builtin_amdgcn_s_barrier()
#define PG8_SCHED __builtin_amdgcn_sched_barrier(0)
    Unit cur, nxt; int ui = 0;
    if (!S.next(0, cur)) return;
    f32x4 acc[2][2][4][2];
#pragma unroll
    for (int a = 0; a < 2; ++a)
#pragma unroll
        for (int b = 0; b < 2; ++b)
#pragma unroll
            for (int m = 0; m < 4; ++m)
#pragma unroll
                for (int n = 0; n < 2; ++n) acc[a][b][m][n] = (f32x4){0.f, 0.f, 0.f, 0.f};
    bf16x8 At[4][2], B0[2][2], B1[2][2]; i32x8 At8[4], B08[2], B18[2];
    unsigned cA0[2], cA1[2], nA0[2], nA1[2];
    PG8_AOFFS(cur, cA0, cA1);
    const char* gA = (const char*)g.A;
    const char* cB = (const char*)g.Bt + S.b_off(cur);
    S.poll_end(cur, S.poll_begin(cur));
    int pend = -1;
    if constexpr (SP2) {
        PG8_STAGE(PG8_SB(0, 0), cB, voffB); PG8_STAGE(PG8_SB(0, 1), cB + hstep, voffB); PG8_STAGE_A(PG8_SA(0, 0), gA, cA0); PG8_STAGE_A(PG8_SA(0, 1), gA, cA1);
        if (wr == 1) PG8_BAR;
        PG8_WAIT_V(2); PG8_BAR;
        PG8_STAGE(PG8_SB(1, 0), cB + kstep, voffB); PG8_STAGE_A(PG8_SA(1, 0), gA + kstep, cA0); PG8_STAGE(PG8_SB(1, 1), cB + hstep + kstep, voffB);
        PG8_WAIT_V(6); PG8_BAR;
    } else {
    PG8_STAGE(PG8_SB(0, 0), cB, voffB); PG8_STAGE_A(PG8_SA(0, 0), gA, cA0); PG8_STAGE(PG8_SB(0, 1), cB + hstep, voffB); PG8_STAGE_A(PG8_SA(0, 1), gA, cA1);
    if (wr == 1) PG8_BAR;
    PG8_WAIT_V(4); PG8_BAR;
    PG8_STAGE(PG8_SB(1, 0), cB + kstep, voffB); PG8_STAGE_A(PG8_SA(1, 0), gA + kstep, cA0); PG8_STAGE(PG8_SB(1, 1), cB + hstep + kstep, voffB);
    PG8_WAIT_V(6); PG8_BAR;
    }
    for (;;) {
        const bool has_next = S.next(ui + 1, nxt);
        const bool halfu = Sched::HANDOFF && __builtin_amdgcn_readfirstlane(cur.nv) <= 128;
        const char* nB = has_next ? (const char*)g.Bt + S.b_off(nxt) : cB;
        const unsigned pv = has_next ? S.poll_begin(nxt) : 0u;
        if (has_next) { PG8_AOFFS(nxt, nA0, nA1);
        } else {
#pragma unroll
            for (int i = 0; i < 2; ++i) { nA0[i] = cA0[i]; nA1[i] = cA1[i]; }
        }
        for (int t = 0; t < nt; t += 2) {
            const bool last = (t == nt - 2);
            if constexpr (Epi::MID_T > 0) { if (t == Epi::MID_T) E.mid(acc, cur, wr, wc, fr, fq); }
            if constexpr (Sched::HANDOFF) if (last && has_next) S.poll_end(nxt, pv);
            const char* a1 = gA + (size_t)(t + 1) * kstep;
            const char* a2 = last ? gA : gA + (size_t)(t + 2) * kstep; const char* b2 = last ? nB : cB + (size_t)(t + 2) * kstep;
            const char* a3 = a2 + kstep; const char* b3 = b2 + kstep;
            if constexpr (SP2) {
            PG8_LDB(B0, 0, 0); PG8_LDB(B1, 0, 1); PG8_SCHED; PG8_LDA(At, 0, 0); PG8_STAGE_A(PG8_SA(1, 1), a1, cA1);
            PG8_WAIT_V(8); if constexpr (Sched::HANDOFF) if (t == 2 && pend >= 0) { S.publish(pend); pend = -1; }
            PG8_WAIT_L(0); PG8_BAR; PG8_MMA(0, 0, At, B0); PG8_MMA(0, 1, At, B1); PG8_BAR; PG8_SCHED;
            PG8_LDA(At, 0, 1); PG8_STAGE(PG8_SB(0, 0), b2, voffB); PG8_STAGE(PG8_SB(0, 1), b2 + hstep, voffB); PG8_STAGE_SEL(PG8_SA(0, 0), a2, cA0, nA0);
            PG8_WAIT_V(8); PG8_WAIT_L(0); PG8_BAR; if (!halfu) { PG8_MMA(1, 0, At, B0); PG8_MMA(1, 1, At, B1); } PG8_BAR; PG8_SCHED;
            PG8_LDB(B0, 1, 0); PG8_LDB(B1, 1, 1); PG8_SCHED; PG8_LDA(At, 1, 0); PG8_STAGE_SEL(PG8_SA(0, 1), a2, cA1, nA1);
            PG8_WAIT_V(8); PG8_WAIT_L(0); PG8_BAR; PG8_MMA(0, 0, At, B0); PG8_MMA(0, 1, At, B1); PG8_BAR; PG8_SCHED;
            PG8_LDA(At, 1, 1); PG8_STAGE(PG8_SB(1, 0), b3, voffB); PG8_STAGE(PG8_SB(1, 1), b3 + hstep, voffB); PG8_STAGE_SEL(PG8_SA(1, 0), a3, cA0, nA0);
            PG8_WAIT_V(8); PG8_WAIT_L(0); PG8_BAR; if (!halfu) { PG8_MMA(1, 0, At, B0); PG8_MMA(1, 1, At, B1); } PG8_BAR; PG8_SCHED;
            } else {
            PG8_LDB(B0, 0, 0); PG8_SCHED; PG8_LDA(At, 0, 0); PG8_STAGE_A(PG8_SA(1, 1), a1, cA1);
            PG8_WAIT_L(8); PG8_BAR; PG8_WAIT_L(0); PG8_MMA(0, 0, At, B0); PG8_BAR; PG8_SCHED;
            PG8_LDB(B1, 0, 1); PG8_STAGE(PG8_SB(0, 0), b2, voffB);
            PG8_BAR; PG8_WAIT_L(0); PG8_MMA(0, 1, At, B1); PG8_BAR;
            PG8_LDA(At, 0, 1); PG8_STAGE_SEL(PG8_SA(0, 0), a2, cA0, nA0);
            PG8_BAR; PG8_WAIT_L(0); PG8_MMA(1, 0, At, B0); PG8_BAR; PG8_SCHED;
            PG8_STAGE(PG8_SB(0, 1), b2 + hstep, voffB);
            PG8_WAIT_V(6); PG8_BAR; PG8_MMA(1, 1, At, B1); PG8_BAR;
            PG8_LDB(B0, 1, 0); PG8_SCHED; PG8_LDA(At, 1, 0); PG8_STAGE_SEL(PG8_SA(0, 1), a2, cA1, nA1);
            PG8_WAIT_L(8); PG8_BAR; PG8_WAIT_L(0); PG8_MMA(0, 0, At, B0); PG8_BAR; PG8_SCHED;
            PG8_LDB(B1, 1, 1); PG8_STAGE(PG8_SB(1, 0), b3, voffB);
            PG8_BAR; PG8_WAIT_L(0); PG8_MMA(0, 1, At, B1); PG8_BAR;
            PG8_LDA(At, 1, 1); PG8_STAGE_SEL(PG8_SA(1, 0), a3, cA0, nA0);
            PG8_BAR; PG8_WAIT_L(0); PG8_MMA(1, 0, At, B0); PG8_BAR; PG8_SCHED;
            PG8_STAGE(PG8_SB(1, 1), b3 + hstep, voffB);
            PG8_WAIT_V(6); PG8_BAR; PG8_MMA(1, 1, At, B1); PG8_BAR;
            }
        }
        if constexpr (ALIGN_EPI) { if (wr == 0) PG8_BAR; }
        if constexpr (FP8) asm volatile("s_nop 15\n\ts_nop 15" ::: "memory");
        E(acc, cur, wr, wc, fr, fq);
        if constexpr (Sched::HANDOFF) { if (pend >= 0) { PG8_WAIT_V(0); S.publish(pend); } pend = cur.pm; }
        if (!has_next) break;
#pragma unroll
        for (int a = 0; a < 2; ++a)
#pragma unroll
            for (int b = 0; b < 2; ++b)
#pragma unroll
                for (int m = 0; m < 4; ++m)
#pragma unroll
                    for (int n = 0; n < 2; ++n) acc[a][b][m][n] = (f32x4){0.f, 0.f, 0.f, 0.f};
        cur = nxt; cB = nB; ++ui;
#pragma unroll
        for (int i = 0; i < 2; ++i) { cA0[i] = nA0[i]; cA1[i] = nA1[i]; }
        if constexpr (ALIGN_EPI) { if (wr == 1) PG8_BAR; }
    }
    PG8_WAIT_V(0);
    if constexpr (Sched::HANDOFF) S.publish(pend);
    if constexpr (!ALIGN_EPI) { if (wr == 0) PG8_BAR; }
    PG8_BAR;
#undef PG8_SA
#undef PG8_SB
#undef PG8_STAGE
#undef PG8_STAGE_A
#undef PG8_STAGE_SEL
#undef PG8_AOFFS
#undef PG8_LDA
#undef PG8_LDB
#undef PG8_MMA
#undef PG8_WAIT_V
#undef PG8_WAIT_L
#undef PG8_BAR
#undef PG8_SCHED
}
}

#define GAS __attribute__((address_space(1)))
#define LAS __attribute__((address_space(3)))
typedef unsigned short bf16;
typedef pg8::f32x4 f32x4;
typedef pg8::f32x2 f32x2;
typedef pg8::u32x4 u32x4;
typedef pg8::u32x2 u32x2;
typedef pg8::bf16x8 bf16x8;
using pg8::cvt_pk_bf16;

constexpr int SEQ = 8192, DM = 1024, M = 2 * SEQ;
constexpr int INW = 6400, C_K = 768, C_V = 1536, C_XR = 2304, C_GL = 3328, C_GM = 4352;
constexpr int NEXP = 32, DEXP = 512, CAP = 16384, MAXTILES = 160;
constexpr float EPS = 1e-6f;
constexpr int NWAVES = 8;
constexpr int LDS_BYTES = 147456;
constexpr int TAB_OFF = 131072 + 1024;

constexpr size_t MiB = 1u << 20;
constexpr size_t WS_CTL = 0, CTL_ZERO_BYTES = 32 * 1024;
constexpr size_t WS_WIN = 2 * MiB;
constexpr size_t WS_WOUT = 18 * MiB;
constexpr size_t WS_WRT = 15 * MiB + 512 * 1024;
constexpr size_t WS_WGU = 20 * MiB;
constexpr size_t WS_WD = 84 * MiB;
constexpr size_t WS_H = 116 * MiB;
constexpr size_t WS_PROJ = 148 * MiB;
constexpr size_t WS_ACT = WS_PROJ, WS_Y = WS_PROJ + 40 * MiB;
constexpr size_t WS_HL = 348 * MiB;
constexpr size_t WS_WPLA = 103 * MiB;
constexpr size_t WS_CA = 413 * MiB;
constexpr int CAW = 1280;
constexpr size_t WS_X1B = WS_HL;
constexpr size_t WS_MERGED = 52 * MiB;
constexpr size_t WS_PC = 380 * MiB;
constexpr size_t WS_G8 = 479 * MiB;
constexpr size_t WS_DELTA = 479 * MiB;
constexpr size_t WS_AGG = 412 * MiB;
constexpr size_t WS_ROUTE = 100 * MiB;
constexpr size_t WS_TOK = 101 * MiB;
constexpr int QK8_COLS = 3328;
constexpr size_t WS_H1F8 = 413 * MiB;
constexpr size_t WS_WG8 = 453 * MiB;
constexpr size_t WS_OG = 453 * MiB;
constexpr size_t WS_LSE = 477 * MiB;
constexpr size_t WS_END = 512 * MiB;
constexpr int CW_CNT = 64;

__device__ __forceinline__ float bf2f(unsigned short b) { return __uint_as_float(((unsigned)b) << 16); }
__device__ __forceinline__ float bflo(unsigned w) { return __uint_as_float(w << 16); }
__device__ __forceinline__ float bfhi(unsigned w) { return __uint_as_float(w & 0xffff0000u); }
__device__ __forceinline__ unsigned short f2bf(float f) { return (unsigned short)(cvt_pk_bf16(f, 0.f) & 0xffffu); }
__device__ __forceinline__ float wave_sum(float v) {
#pragma unroll
    for (int o = 1; o < 64; o <<= 1) v += __shfl_xor(v, o);
    return v;
}
__device__ __forceinline__ float wave_max(float v) {
#pragma unroll
    for (int o = 1; o < 64; o <<= 1) v = fmaxf(v, __shfl_xor(v, o));
    return v;
}
__device__ __forceinline__ unsigned pk4_fp8(float a, float b, float c, float d) { int w = 0; w = __builtin_amdgcn_cvt_pk_fp8_f32(a, b, w, false); w = __builtin_amdgcn_cvt_pk_fp8_f32(c, d, w, true); return (unsigned)w; }
constexpr float WSCALE = 32.0f, WINV = 1.0f / 32.0f;
__device__ __forceinline__ void lds_barrier() { asm volatile("s_waitcnt lgkmcnt(0)\n\ts_barrier" ::: "memory"); }
__device__ __forceinline__ void st_wt16(void* p, u32x4 v) { asm volatile("global_store_dwordx4 %0, %1, off sc1\n\ts_nop 1" :: "v"(p), "v"(v) : "memory"); }
__device__ __forceinline__ int team_rows64(int c) { const int x = c & 7, off = c >> 3; return 32 * x + 4 * (off & 7) + (off >> 3); }
__device__ __forceinline__ float sigmoid_f(float x) { return __builtin_amdgcn_rcpf(1.0f + __builtin_amdgcn_exp2f(-1.4426950408889634f * x)); }
__device__ __forceinline__ float gelu_tanh_f(float x) { const float u = 0.7978845608028654f * (x + 0.044715f * x * x * x); return x * sigmoid_f(2.0f * u); }

__device__ const unsigned char BUCKET[3][132] = {
 {0,1,2,3,4,5,6,7,8,9,10,11,12,13,14,15,16,16,16,16,16,16,17,17,17,17,17,17,17,17,18,18,18,18,18,18,18,18,18,18,19,19,19,19,19,19,19,19,19,19,19,19,19,19,20,20,20,20,20,20,20,20,20,20,20,20,20,20,20,20,20,20,20,21,21,21,21,21,21,21,21,21,21,21,21,21,21,21,21,21,21,21,21,21,21,21,21,21,21,22,22,22,22,22,22,22,22,22,22,22,22,22,22,22,22,22,22,22,22,22,22,22,22,22,22,22,22,22,22,0,0,0},
 {0,4,8,12,16,16,17,17,18,18,19,19,19,19,20,20,20,20,20,21,21,21,21,21,21,22,22,22,22,22,22,22,22,22,23,23,23,23,23,23,23,23,23,23,23,23,24,24,24,24,24,24,24,24,24,24,24,24,24,24,24,24,25,25,25,25,25,25,25,25,25,25,25,25,25,25,25,25,25,25,25,25,25,26,26,26,26,26,26,26,26,26,26,26,26,26,26,26,26,26,26,26,26,26,26,26,26,26,26,26,26,26,26,27,27,27,27,27,27,27,27,27,27,27,27,27,27,27,27,0,0,0},
 {0,16,18,19,20,21,21,22,22,23,23,23,24,24,24,24,25,25,25,25,25,26,26,26,26,26,26,26,26,27,27,27,27,27,27,27,27,27,27,28,28,28,28,28,28,28,28,28,28,28,28,28,29,29,29,29,29,29,29,29,29,29,29,29,29,29,29,29,29,29,30,30,30,30,30,30,30,30,30,30,30,30,30,30,30,30,30,30,30,30,30,30,30,30,30,31,31,31,31,31,31,31,31,31,31,31,31,31,31,31,31,31,31,31,31,31,31,31,31,31,31,31,31,31,31,31,31,31,31,0,0,0}};

__device__ __forceinline__ u32x4 pair16(u32x2 a, u32x2 b) {
    const auto x = __builtin_amdgcn_permlane16_swap(a.x, b.x, false, false), y = __builtin_amdgcn_permlane16_swap(a.y, b.y, false, false);
    u32x4 r; r.x = x[0]; r.y = y[0]; r.z = x[1]; r.w = y[1]; return r;
}
__device__ __forceinline__ float sig255(float x) { return __builtin_amdgcn_rcpf(__builtin_fmaf(__builtin_amdgcn_exp2f(-1.4426950408889634f * x), 1.0f / 255.0f, 1.0f / 255.0f)); }
__device__ __forceinline__ unsigned pk4_u8(float a, float b, float c, float d) {
    unsigned r = __builtin_amdgcn_cvt_pk_u8_f32(__builtin_rintf(a), 0, 0u); r = __builtin_amdgcn_cvt_pk_u8_f32(__builtin_rintf(b), 1, r);
    r = __builtin_amdgcn_cvt_pk_u8_f32(__builtin_rintf(c), 2, r); return __builtin_amdgcn_cvt_pk_u8_f32(__builtin_rintf(d), 3, r);
}
__device__ __forceinline__ float ub0(unsigned w) { return (float)(w & 0xffu); }
__device__ __forceinline__ float ub1(unsigned w) { return (float)((w >> 8) & 0xffu); }
__device__ __forceinline__ float ub2(unsigned w) { return (float)((w >> 16) & 0xffu); }
__device__ __forceinline__ float ub3(unsigned w) { return (float)(w >> 24); }
struct EpiProj {
    static constexpr bool PERM = true; static constexpr int MID_T = 0;
    bf16* O; unsigned char* G8; int pn0;
    __device__ __forceinline__ void operator()(const f32x4 (&acc)[2][2][4][2], const pg8::Unit& uu, int wr, int wc, int fr, int fq) const {
        pg8::Unit u = uu; u.pn += pn0;
        const int row0 = u.pm * 256 + wr * 64 + fr, col0 = u.pn * 256 + wc * 32 + 8 * fq;
        const int mode = u.pn < 3 ? 0 : (u.pn < 17 ? 1 : 3);
        if (mode == 3) {
            const int gate = (u.pn - 17) >> 2, pnq = (u.pn - 17) & 3;
            unsigned char* gb = G8 + (size_t)u.pm * 524288 + (size_t)(((pnq * 2 + gate) * 8 + wr * 4 + wc) * 8192 + (fr + 16 * fq) * 16);
#pragma unroll
            for (int ai = 0; ai < 2; ++ai)
#pragma unroll
                for (int m = 0; m < 4; ++m) { u32x4 w;
                    { const f32x4 v0 = acc[ai][0][m][0], v1 = acc[ai][0][m][1]; w.x = pk4_u8(sig255(v0[0]), sig255(v0[1]), sig255(v0[2]), sig255(v0[3])); w.y = pk4_u8(sig255(v1[0]), sig255(v1[1]), sig255(v1[2]), sig255(v1[3])); }
                    { const f32x4 v0 = acc[ai][1][m][0], v1 = acc[ai][1][m][1]; w.z = pk4_u8(sig255(v0[0]), sig255(v0[1]), sig255(v0[2]), sig255(v0[3])); w.w = pk4_u8(sig255(v1[0]), sig255(v1[1]), sig255(v1[2]), sig255(v1[3])); }
                    *(u32x4*)(gb + (ai * 4 + m) * 1024) = w; }
            return; }
#pragma unroll
        for (int ai = 0; ai < 2; ++ai)
#pragma unroll
            for (int m = 0; m < 4; ++m) { bf16* rowp = O + (size_t)(row0 + ai * 128 + m * 16) * INW + col0;
#pragma unroll
                for (int bj = 0; bj < 2; ++bj) { f32x4 v0 = acc[ai][bj][m][0], v1 = acc[ai][bj][m][1];
                    if (mode == 0) { v0 = v0 * 0.125f; v1 = v1 * 0.125f; }
                    else if (mode == 2) {
#pragma unroll
                        for (int j = 0; j < 4; ++j) { v0[j] = gelu_tanh_f(v0[j]); v1[j] = gelu_tanh_f(v1[j]); } }
                    u32x4 w; w.x = cvt_pk_bf16(v0[0], v0[1]); w.y = cvt_pk_bf16(v0[2], v0[3]); w.z = cvt_pk_bf16(v1[0], v1[1]); w.w = cvt_pk_bf16(v1[2], v1[3]);
                    *(u32x4*)(rowp + bj * 128) = w; } }
    }
};
template <bool HAS_ADD> struct EpiGate {
    static constexpr bool PERM = true; static constexpr int MID_T = 0;
    bf16* O; const bf16* PROJ; const bf16* ADD; int gcol0, pad;
    __device__ __forceinline__ void operator()(const f32x4 (&acc)[2][2][4][2], const pg8::Unit& u, int wr, int wc, int fr, int fq) const {
        const int row0 = u.pm * 256 + wr * 64 + fr, col0 = u.pn * 256 + wc * 32 + 8 * fq;
#pragma unroll
        for (int ai = 0; ai < 2; ++ai) {
            u32x4 gv[4][2], av[4][2];
#pragma unroll
            for (int m = 0; m < 4; ++m)
#pragma unroll
                for (int bj = 0; bj < 2; ++bj) { const size_t r = (size_t)(row0 + ai * 128 + m * 16); const int c = col0 + bj * 128;
                    gv[m][bj] = *(const u32x4*)(PROJ + r * INW + gcol0 + c); if (HAS_ADD) av[m][bj] = *(const u32x4*)(ADD + r * DM + c); }
#pragma unroll
            for (int m = 0; m < 4; ++m)
#pragma unroll
                for (int bj = 0; bj < 2; ++bj) { const size_t r = (size_t)(row0 + ai * 128 + m * 16); const int c = col0 + bj * 128; const u32x4 g = gv[m][bj];
                    f32x4 v0 = acc[ai][bj][m][0], v1 = acc[ai][bj][m][1];
                    v0[0] *= bflo(g.x); v0[1] *= bfhi(g.x); v0[2] *= bflo(g.y); v0[3] *= bfhi(g.y);
                    v1[0] *= bflo(g.z); v1[1] *= bfhi(g.z); v1[2] *= bflo(g.w); v1[3] *= bfhi(g.w);
                    if (HAS_ADD) { const u32x4 a = av[m][bj];
                        v0[0] += bflo(a.x); v0[1] += bfhi(a.x); v0[2] += bflo(a.y); v0[3] += bfhi(a.y);
                        v1[0] += bflo(a.z); v1[1] += bfhi(a.z); v1[2] += bflo(a.w); v1[3] += bfhi(a.w); }
                    u32x4 w; w.x = cvt_pk_bf16(v0[0], v0[1]); w.y = cvt_pk_bf16(v0[2], v0[3]); w.z = cvt_pk_bf16(v1[0], v1[1]); w.w = cvt_pk_bf16(v1[2], v1[3]);
                    *(u32x4*)(O + r * DM + c) = w; }
        }
    }
};
struct EpiGate8 {
    static constexpr bool PERM = true; static constexpr int MID_T = 0;
    unsigned char* G8; bf16* O;
    static __device__ __forceinline__ float sg(float x) { return __builtin_amdgcn_rcpf(__builtin_fmaf(__builtin_amdgcn_exp2f((-1.4426950408889634f * WINV) * x), 1.0f / 255.0f, 1.0f / 255.0f)); }
    __device__ __forceinline__ void operator()(const f32x4 (&acc)[2][2][4][2], const pg8::Unit& u, int wr, int wc, int fr, int fq) const {
        if (u.pn >= 8) { const int pq = u.pn - 8; const float sc = pq < 3 ? 0.125f * WINV : WINV;
            const int row0 = u.pm * 256 + wr * 64 + fr, col0 = pq * 256 + wc * 32 + 8 * fq;
#pragma unroll
            for (int ai = 0; ai < 2; ++ai)
#pragma unroll
                for (int m = 0; m < 4; ++m) { bf16* rowp = O + (size_t)(row0 + ai * 128 + m * 16) * INW + col0;
#pragma unroll
                    for (int bj = 0; bj < 2; ++bj) { const f32x4 v0 = acc[ai][bj][m][0] * sc, v1 = acc[ai][bj][m][1] * sc;
                        u32x4 w; w.x = cvt_pk_bf16(v0[0], v0[1]); w.y = cvt_pk_bf16(v0[2], v0[3]); w.z = cvt_pk_bf16(v1[0], v1[1]); w.w = cvt_pk_bf16(v1[2], v1[3]);
                        *(u32x4*)(rowp + bj * 128) = w; } }
            return; }
        const int gate = u.pn >> 2, pnq = u.pn & 3;
        unsigned char* gb = G8 + (size_t)u.pm * 524288 + (size_t)(((pnq * 2 + gate) * 8 + wr * 4 + wc) * 8192 + (fr + 16 * fq) * 16);
#pragma unroll
        for (int ai = 0; ai < 2; ++ai)
#pragma unroll
            for (int m = 0; m < 4; ++m) { u32x4 w;
                { const f32x4 v0 = acc[ai][0][m][0], v1 = acc[ai][0][m][1]; w.x = pk4_u8(sg(v0[0]), sg(v0[1]), sg(v0[2]), sg(v0[3])); w.y = pk4_u8(sg(v1[0]), sg(v1[1]), sg(v1[2]), sg(v1[3])); }
                { const f32x4 v0 = acc[ai][1][m][0], v1 = acc[ai][1][m][1]; w.z = pk4_u8(sg(v0[0]), sg(v0[1]), sg(v0[2]), sg(v0[3])); w.w = pk4_u8(sg(v1[0]), sg(v1[1]), sg(v1[2]), sg(v1[3])); }
                *(u32x4*)(gb + (ai * 4 + m) * 1024) = w; }
    }
};
struct EpiGateMid {
    static constexpr bool PERM = true; static constexpr int MID_T = 16;
    bf16* O; const unsigned char* G8; bool wt;
    __device__ __forceinline__ void mid(f32x4 (&acc)[2][2][4][2], const pg8::Unit& u, int wr, int wc, int fr, int fq) const {
        int opq = 0; asm volatile("" : "+v"(opq));
        const unsigned char* ga = G8 + (size_t)u.pm * 524288 + (size_t)((u.pn * 2 * 8 + wr * 4 + wc) * 8192 + (fr + 16 * fq + opq) * 16); const unsigned char* gl = ga + 65536;
#pragma unroll
        for (int ai = 0; ai < 2; ++ai) {
            u32x4 av[4], lv[4];
#pragma unroll
            for (int m = 0; m < 4; ++m) { av[m] = *(const u32x4*)(ga + (ai * 4 + m) * 1024); lv[m] = __builtin_nontemporal_load((const u32x4*)(gl + (ai * 4 + m) * 1024)); }
#pragma unroll
            for (int m = 0; m < 4; ++m) { const u32x4 a = av[m], l = lv[m];
#define GQ(L, A) ((L) * __builtin_amdgcn_rcpf(fmaxf((A), 1e-28f)))
                acc[ai][0][m][0][0] *= GQ(ub0(l.x), ub0(a.x)); acc[ai][0][m][0][1] *= GQ(ub1(l.x), ub1(a.x)); acc[ai][0][m][0][2] *= GQ(ub2(l.x), ub2(a.x)); acc[ai][0][m][0][3] *= GQ(ub3(l.x), ub3(a.x));
                acc[ai][0][m][1][0] *= GQ(ub0(l.y), ub0(a.y)); acc[ai][0][m][1][1] *= GQ(ub1(l.y), ub1(a.y)); acc[ai][0][m][1][2] *= GQ(ub2(l.y), ub2(a.y)); acc[ai][0][m][1][3] *= GQ(ub3(l.y), ub3(a.y));
                acc[ai][1][m][0][0] *= GQ(ub0(l.z), ub0(a.z)); acc[ai][1][m][0][1] *= GQ(ub1(l.z), ub1(a.z)); acc[ai][1][m][0][2] *= GQ(ub2(l.z), ub2(a.z)); acc[ai][1][m][0][3] *= GQ(ub3(l.z), ub3(a.z));
                acc[ai][1][m][1][0] *= GQ(ub0(l.w), ub0(a.w)); acc[ai][1][m][1][1] *= GQ(ub1(l.w), ub1(a.w)); acc[ai][1][m][1][2] *= GQ(ub2(l.w), ub2(a.w)); acc[ai][1][m][1][3] *= GQ(ub3(l.w), ub3(a.w));
#undef GQ
            }
            asm volatile("" ::: "memory");
        }
    }
    __device__ __forceinline__ void operator()(const f32x4 (&acc)[2][2][4][2], const pg8::Unit& u, int wr, int wc, int fr, int fq) const {
        const int row0 = u.pm * 256 + wr * 64 + fr, col0 = u.pn * 256 + wc * 32 + 8 * fq;
        const unsigned char* ga = G8 + (size_t)u.pm * 524288 + (size_t)((u.pn * 2 * 8 + wr * 4 + wc) * 8192 + (fr + 16 * fq) * 16);
        constexpr float S = 1.0f / 255.0f;
#pragma unroll
        for (int ai = 0; ai < 2; ++ai) {
            u32x4 gv[4];
#pragma unroll
            for (int m = 0; m < 4; ++m) gv[m] = __builtin_nontemporal_load((const u32x4*)(ga + (ai * 4 + m) * 1024));
#pragma unroll
            for (int m = 0; m < 4; ++m)
#pragma unroll
                for (int bj = 0; bj < 2; ++bj) { const size_t r = (size_t)(row0 + ai * 128 + m * 16); const int c = col0 + bj * 128; const unsigned g0 = bj ? gv[m].z : gv[m].x, g1 = bj ? gv[m].w : gv[m].y;
                    f32x4 v0 = acc[ai][bj][m][0], v1 = acc[ai][bj][m][1];
                    v0[0] *= fmaxf(ub0(g0), 1e-28f) * S; v0[1] *= fmaxf(ub1(g0), 1e-28f) * S; v0[2] *= fmaxf(ub2(g0), 1e-28f) * S; v0[3] *= fmaxf(ub3(g0), 1e-28f) * S;
                    v1[0] *= fmaxf(ub0(g1), 1e-28f) * S; v1[1] *= fmaxf(ub1(g1), 1e-28f) * S; v1[2] *= fmaxf(ub2(g1), 1e-28f) * S; v1[3] *= fmaxf(ub3(g1), 1e-28f) * S;
                    u32x4 w; w.x = cvt_pk_bf16(v0[0], v0[1]); w.y = cvt_pk_bf16(v0[2], v0[3]); w.z = cvt_pk_bf16(v1[0], v1[1]); w.w = cvt_pk_bf16(v1[2], v1[3]);
                    st_wt16(O + r * DM + c, w); }
        }
    }
};
struct EpiSwiglu {
    static constexpr bool PERM = true; static constexpr int MID_T = 0;
    unsigned char* O;
    __device__ __forceinline__ void operator()(const f32x4 (&acc)[2][2][4][2], const pg8::Unit& u, int wr, int wc, int fr, int fq) const {
        const int row0 = u.pm * 256 + wr * 64 + fr + (fq & 1) * 16, col0 = u.pn * 128 + wc * 32 + 8 * (fq & 2);
        const int na = __builtin_amdgcn_readfirstlane(u.nv) <= 128 ? 1 : 2;
#pragma unroll
        for (int ai = 0; ai < 2; ++ai) { if (ai >= na) break;
#pragma unroll
            for (int mp = 0; mp < 2; ++mp) { u32x2 w[2];
#pragma unroll
                for (int mm = 0; mm < 2; ++mm) { const int m = 2 * mp + mm; f32x4 v0, v1;
#pragma unroll
                    for (int j = 0; j < 4; ++j) { const float a0 = acc[ai][0][m][0][j], a1 = acc[ai][0][m][1][j];
                        constexpr float IW2 = WSCALE * WSCALE, NL = -WINV * 1.4426950408889634f;
                        v0[j] = a0 * acc[ai][1][m][0][j] * __builtin_amdgcn_rcpf(__builtin_fmaf(__builtin_amdgcn_exp2f(a0 * NL), IW2, IW2));
                        v1[j] = a1 * acc[ai][1][m][1][j] * __builtin_amdgcn_rcpf(__builtin_fmaf(__builtin_amdgcn_exp2f(a1 * NL), IW2, IW2)); }
                    w[mm].x = pk4_fp8(v0[0], v0[1], v0[2], v0[3]); w[mm].y = pk4_fp8(v1[0], v1[1], v1[2], v1[3]); }
                st_wt16(O + (size_t)(row0 + ai * 128 + mp * 32) * DEXP + col0, pair16(w[0], w[1])); } }
    }
};
struct EpiPlain {
    static constexpr bool PERM = true; static constexpr int MID_T = 0;
    unsigned char* O; int ldc; float scale;
    __device__ __forceinline__ void operator()(const f32x4 (&acc)[2][2][4][2], const pg8::Unit& u, int wr, int wc, int fr, int fq) const {
#pragma unroll
        for (int ai = 0; ai < 2; ++ai)
#pragma unroll
            for (int m = 0; m < 4; ++m) { unsigned char* bp = O + (size_t)(((u.pm * 4 + wr + 2 * ai) * 8 + (u.pn >> 1) * 4 + m) * 16 + (u.pn & 1) * 8 + wc) * 1024 + (fr + 16 * fq) * 16;
#pragma unroll
                for (int bj = 0; bj < 2; ++bj) { const f32x4 v0 = acc[ai][bj][m][0] * scale, v1 = acc[ai][bj][m][1] * scale;
                    u32x4 w; w.x = cvt_pk_bf16(v0[0], v0[1]); w.y = cvt_pk_bf16(v0[2], v0[3]); w.z = cvt_pk_bf16(v1[0], v1[1]); w.w = cvt_pk_bf16(v1[2], v1[3]);
                    st_wt16(bp + bj * 4096, w); } }
    }
};

constexpr float YSCALE = 4.0f, YINV = 0.25f;
struct EpiY8 {
    static constexpr bool PERM = true; static constexpr int MID_T = 0;
    unsigned char* O; float scale;
    __device__ __forceinline__ void operator()(const f32x4 (&acc)[2][2][4][2], const pg8::Unit& u, int wr, int wc, int fr, int fq) const {
        const int row0 = u.pm * 256 + wr * 64 + fr + (fq & 1) * 16, col0 = u.pn * 256 + wc * 32 + 8 * (fq & 2);
        const int na = __builtin_amdgcn_readfirstlane(u.nv) <= 128 ? 1 : 2;
#pragma unroll
        for (int ai = 0; ai < 2; ++ai) { if (ai >= na) break;
#pragma unroll
            for (int mp = 0; mp < 2; ++mp) { unsigned char* rowp = O + (size_t)(row0 + ai * 128 + mp * 32) * DM + col0;
#pragma unroll
                for (int bj = 0; bj < 2; ++bj) { u32x2 w[2];
#pragma unroll
                    for (int mm = 0; mm < 2; ++mm) { const int m = 2 * mp + mm; const f32x4 v0 = acc[ai][bj][m][0] * scale, v1 = acc[ai][bj][m][1] * scale;
                        w[mm].x = pk4_fp8(v0[0], v0[1], v0[2], v0[3]); w[mm].y = pk4_fp8(v1[0], v1[1], v1[2], v1[3]); }
                    *(u32x4*)(rowp + bj * 128) = pair16(w[0], w[1]); }
                asm volatile("" ::: "memory"); } }
    }
};

constexpr int XL_OFF = 192;
constexpr int CW_CT = 1024, CW_TMO2 = 960;
template <int MODE> struct MoeOrderT {
    static constexpr int A_AUX = MODE == 1 ? 16 : 0; static constexpr bool HANDOFF = true;
    const LAS int* tab; const int* tok; const unsigned* cnt; unsigned* ctl; int G, c, rb, gather; size_t bstride;
    __device__ __forceinline__ bool next(int i, pg8::Unit& u) const {
        if (i >= 32) return false;
        const int ent = tab[XL_OFF + 32 * MODE + i]; if (ent < 0) return false;
        const int t = ent >> 2, info = tab[1 + t]; u.pm = t; u.pn = ent & 3; u.e = info & 255; u.r0 = info >> 8; u.nv = (int)cnt[u.e] - u.r0; return true;
    }
    __device__ __forceinline__ unsigned a_off(const pg8::Unit& u, int r) const {
        if (MODE == 0) { const int n = (int)cnt[u.e]; int idx = u.r0 + r; idx = idx < n ? idx : n - 1; const int t = tok[u.e * CAP + idx]; return (unsigned)t * (unsigned)rb; }
        return (unsigned)(u.pm * 256 + r) * (unsigned)rb;
    }
    __device__ __forceinline__ size_t b_off(const pg8::Unit& u) const { return (size_t)u.e * bstride + (size_t)u.pn * 256 * rb; }
    __device__ __forceinline__ void publish(int pm) const {
        if (MODE == 0) { if ((threadIdx.x & 63) == 0) __hip_atomic_fetch_add(ctl + CW_CT + 16 * pm, 1u, __ATOMIC_RELAXED, __HIP_MEMORY_SCOPE_AGENT); }
    }
    __device__ __forceinline__ unsigned poll_begin(const pg8::Unit& u) const {
        if (MODE == 1) return __hip_atomic_load(ctl + CW_CT + 16 * u.pm, __ATOMIC_RELAXED, __HIP_MEMORY_SCOPE_AGENT);
        return 0u;
    }
    __device__ __forceinline__ void poll_end(const pg8::Unit& u, unsigned v) const {
        if (MODE == 1) { unsigned sp = 0u; v = (unsigned)__builtin_amdgcn_readfirstlane((int)v);
            while (v < 32u) {
                __builtin_amdgcn_s_sleep(2);
                if ((++sp & 255u) == 0u) { if (__hip_atomic_load(ctl + CW_TMO2, __ATOMIC_RELAXED, __HIP_MEMORY_SCOPE_AGENT) != 0u) break;
                    if (sp > (1u << 20)) { __hip_atomic_store(ctl + CW_TMO2, 1u, __ATOMIC_RELAXED, __HIP_MEMORY_SCOPE_AGENT); break; } }
                v = (unsigned)__builtin_amdgcn_readfirstlane((int)__hip_atomic_load(ctl + CW_CT + 16 * u.pm, __ATOMIC_RELAXED, __HIP_MEMORY_SCOPE_AGENT)); }
            asm volatile("" ::: "memory"); }
    }
};
__device__ __forceinline__ void build_moe_table(LAS int* tab, const unsigned* cnt, int tid) {
    if (tid < 64) { const int e = tid; const int n = e < NEXP ? (int)cnt[e] : 0; const int tiles = (n + 255) >> 8; int incl = tiles;
#pragma unroll
        for (int o = 1; o < 32; o <<= 1) { const int v = __shfl_up(incl, o); if (tid >= o) incl += v; }
        const int first = incl - tiles;
        if (e < NEXP) for (int k = 0; k < tiles; ++k) tab[1 + first + k] = e | ((k * 256) << 8);
        { const int x = (int)blockIdx.x & 7, G = (int)gridDim.x, W = (G - x + 7) >> 3, r = (int)blockIdx.x >> 3, mode = tid >> 5, i = tid & 31;
          const int f0 = __shfl(first, x), f1 = __shfl(first, x + 8), f2 = __shfl(first, x + 16), f3 = __shfl(first, x + 24);
          const int n0 = __shfl(tiles, x), n1 = __shfl(tiles, x + 8), n2 = __shfl(tiles, x + 16), n3 = __shfl(tiles, x + 24), nx = 4 * (n0 + n1 + n2 + n3);
          int j = nx;
          if (mode == 0) j = i * W + r;
          else if (nx > 0) {
              const int K = (nx + W - 1) / W, R = nx - (K - 1) * W, nL = R, nS = W - R; const bool mineS = r >= R; const int myidx = mineS ? r - R : r;
              int tL = 3 * K, tS = 3 * (K - 1), done = 0, turn = 0;
              while (done < nx) { const bool pickS = nS > 0 && tS <= tL; const int avail = pickS ? nS : nL, left = nx - done, m = avail < left ? avail : left;
                  if (pickS == mineS) { if (turn == i && myidx < m) j = done + myidx; ++turn; }
                  if (pickS) tS += 2; else tL += 2;
                  done += m; } }
          int ent = -1;
          if (j < nx) { int q = j >> 2, t;
              if (q < n0) t = f0 + q; else { q -= n0; if (q < n1) t = f1 + q; else { q -= n1; if (q < n2) t = f2 + q; else t = f3 + q - n2; } }
              ent = (t << 2) | (j & 3); }
          tab[XL_OFF + tid] = ent; }
        if (e == NEXP - 1) tab[0] = incl; }
}

typedef GAS unsigned gu32;
#define RLX_AGENT __ATOMIC_RELAXED, __HIP_MEMORY_SCOPE_AGENT
#define XB_TMO      128
#define XB_XCNT(j)  (256  + 64 * (j))
#define XB_XSUB(j)  (1280 + 64 * (j))
#define XB_XGEN(j)  (2304 + 64 * (j))
#define XB_TOP      3328
#define XB_TOPGEN   3392
#define XCD_BAR_WORDS 3456
#define XB_SPIN_CAP (1u << 18)
constexpr int CW_BAR_TMO = 4096 + XB_TMO;
__device__ __forceinline__ unsigned xb_ld(unsigned* p)              { return __hip_atomic_load(p, __ATOMIC_RELAXED, __HIP_MEMORY_SCOPE_AGENT); }
__device__ __forceinline__ unsigned xb_add(unsigned* p, unsigned v) { return __hip_atomic_fetch_add(p, v, __ATOMIC_RELAXED, __HIP_MEMORY_SCOPE_AGENT); }
__device__ __forceinline__ unsigned xb_xcc_id() { return (unsigned)__builtin_amdgcn_s_getreg((3 << 11) | 20) & 0xFu; }
#define XB_SPIN(cond, bar) do { unsigned _sp = 0; while (cond) { __builtin_amdgcn_s_sleep(1); \
    if ((++_sp & 255u) == 0u) { if (xb_ld(&(bar)[XB_TMO])) break; if (_sp > XB_SPIN_CAP) { atomicAdd(&(bar)[XB_TMO], 1u); break; } } } } while (0)
struct XcdBarrier { unsigned* bar; unsigned x; volatile LAS unsigned* st; };
__device__ __forceinline__ XcdBarrier xcd_barrier_post(unsigned* bar, volatile LAS unsigned* st) {
    XcdBarrier b; b.bar = bar; b.x = xb_xcc_id(); b.st = st;
    if (threadIdx.x == 0) (void)xb_add(&bar[XB_XCNT(b.x)], 1u);
    return b;
}
__device__ __forceinline__ void xcd_barrier_complete(unsigned* bar, unsigned x, unsigned& nloc, unsigned& nx) {
    const unsigned G = gridDim.x * gridDim.y * gridDim.z;
    unsigned sum, cnt, mine, sp = 0u;
    for (;;) {
        sum = 0u; cnt = 0u; mine = 0u;
#pragma unroll
        for (unsigned j = 0; j < 16; ++j) { const unsigned c = xb_ld(&bar[XB_XCNT(j)]); sum += c; cnt += (c > 0u) ? 1u : 0u; mine = (j == x) ? c : mine; }
        if (sum == G) break;
        __builtin_amdgcn_s_sleep(1);
        if ((++sp & 255u) == 0u) { if (xb_ld(&bar[XB_TMO])) break; if (sp > XB_SPIN_CAP) { atomicAdd(&bar[XB_TMO], 1u); break; } }
    }
    nloc = mine > 0u ? mine : 1u; nx = cnt > 0u ? cnt : 1u;
}
__device__ __forceinline__ void xcd_barrier(const XcdBarrier& b) {
    asm volatile("s_waitcnt vmcnt(0)" ::: "memory");
    __syncthreads();
    if (threadIdx.x == 0) {
        unsigned* bar = b.bar;
        __builtin_amdgcn_s_waitcnt(0);
        unsigned nloc = b.st[0], nx = b.st[1];
        if (nloc == 0u) { xcd_barrier_complete(bar, b.x, nloc, nx); b.st[0] = nloc; b.st[1] = nx; }
        const unsigned old = xb_add(&bar[XB_XSUB(b.x)], 1u);
        const unsigned gen = old / nloc;
        if (old + 1u == (gen + 1u) * nloc) {
            __builtin_amdgcn_fence(__ATOMIC_RELEASE, "agent");
            asm volatile("s_waitcnt vmcnt(0)" ::: "memory");
            const unsigned og = xb_add(&bar[XB_TOP], 1u);
            const unsigned tg = og / nx;
            if (og + 1u == (tg + 1u) * nx) xb_add(&bar[XB_TOPGEN], 1u);
            else XB_SPIN(xb_ld(&bar[XB_TOPGEN]) == tg, bar);
            __builtin_amdgcn_fence(__ATOMIC_ACQUIRE, "agent");
            xb_add(&bar[XB_XGEN(b.x)], 1u);
            asm volatile("s_waitcnt vmcnt(0)" ::: "memory");
        } else {
            XB_SPIN(xb_ld(&bar[XB_XGEN(b.x)]) == gen, bar);
            __builtin_amdgcn_fence(__ATOMIC_ACQUIRE, "agent");
            asm volatile("s_waitcnt vmcnt(0)" ::: "memory");
        }
    }
    __syncthreads();
}

constexpr int CW_TEAM = 128;
__device__ __forceinline__ void team_barrier(unsigned* ctl, unsigned target) {
    asm volatile("s_waitcnt vmcnt(0)" ::: "memory");
    __syncthreads();
    if (threadIdx.x == 0) {
        unsigned* w = ctl + CW_TEAM + 8 * (((int)blockIdx.x & 7) * 8 + (((int)blockIdx.x >> 3) & 7));
        (void)xb_add(w, 1u);
        unsigned sp = 0u;
        while (xb_ld(w) < target) { __builtin_amdgcn_s_sleep(1);
            if ((++sp & 255u) == 0u) { if (xb_ld(ctl + CW_BAR_TMO)) break; if (sp > XB_SPIN_CAP) { atomicAdd(ctl + CW_BAR_TMO, 1u); break; } } }
        __builtin_amdgcn_fence(__ATOMIC_ACQUIRE, "agent");
        asm volatile("s_waitcnt vmcnt(0)" ::: "memory");
    }
    __syncthreads();
}

#ifndef REPEAT_PHASE
#define REPEAT_PHASE -1
#endif
struct P { const float* in[20]; float* out; unsigned char* ws; int ph_lo, ph_hi; };
constexpr int CW_BAR = 4096;
constexpr int MISC_OFF = 131072 + 320;

__device__ __forceinline__ void transpose_item(const float* W, int ldw, bf16* WT, int K, int drow0, int k0, int n0, LAS float* scr, int lane) {
#pragma unroll 8
    for (int i = 0; i < 32; ++i) { const int kk = 2 * i + (lane >> 5); scr[kk * 33 + (lane & 31)] = __builtin_nontemporal_load(W + (size_t)(k0 + kk) * ldw + n0 + (lane & 31)); }
    asm volatile("s_waitcnt lgkmcnt(0)" ::: "memory");
    const int c = lane & 7;
#pragma unroll
    for (int j = 0; j < 4; ++j) { const int n = (lane >> 3) + 8 * j; const LAS float* s = scr + (8 * c) * 33 + n;
        u32x4 o; o.x = cvt_pk_bf16(s[0 * 33], s[1 * 33]); o.y = cvt_pk_bf16(s[2 * 33], s[3 * 33]); o.z = cvt_pk_bf16(s[4 * 33], s[5 * 33]); o.w = cvt_pk_bf16(s[6 * 33], s[7 * 33]);
        *(u32x4*)(WT + (size_t)(drow0 + n) * K + k0 + 8 * c) = o; }
    asm volatile("s_waitcnt lgkmcnt(0)" ::: "memory");
}
__device__ __forceinline__ void transpose_item_f8(const float* W, int ldw, unsigned char* WT, int K, int drow0, int k0, int n0, LAS float* scr, int lane) {
#pragma unroll 8
    for (int i = 0; i < 32; ++i) { const int kk = 2 * i + (lane >> 5); scr[kk * 33 + (lane & 31)] = __builtin_nontemporal_load(W + (size_t)(k0 + kk) * ldw + n0 + (lane & 31)); }
    asm volatile("s_waitcnt lgkmcnt(0)" ::: "memory");
    const int c = lane & 7;
#pragma unroll
    for (int j = 0; j < 4; ++j) { const int n = (lane >> 3) + 8 * j; const LAS float* s = scr + (8 * c) * 33 + n;
        u32x2 o; o.x = pk4_fp8(s[0 * 33] * WSCALE, s[1 * 33] * WSCALE, s[2 * 33] * WSCALE, s[3 * 33] * WSCALE); o.y = pk4_fp8(s[4 * 33] * WSCALE, s[5 * 33] * WSCALE, s[6 * 33] * WSCALE, s[7 * 33] * WSCALE);
        *(u32x2*)(WT + (size_t)(drow0 + n) * K + k0 + 8 * c) = o; }
    asm volatile("s_waitcnt lgkmcnt(0)" ::: "memory");
}
struct TItem { const float* W; unsigned char* WT; int K, drow0, k0, n0; };
__device__ __forceinline__ void moe_item(const P& p, int it, TItem& t) {
    unsigned char* ws = p.ws;
    if (it < 32 * 512) { const int e = it >> 9, q = it & 511, kb = q >> 5, nb = q & 31, n0 = 32 * nb, j = n0 & 511, isu = n0 >> 9;
        t.W = p.in[17] + (size_t)e * 1024 * 1024; t.WT = ws + WS_WGU + (size_t)e * 1024 * 1024; t.K = 1024; t.drow0 = 256 * (j >> 7) + 128 * isu + (j & 127); t.k0 = 64 * kb; t.n0 = n0; }
    else { const int r = it - 32 * 512, e = r >> 8, q = r & 255, kb = q >> 5, nb = q & 31;
        t.W = p.in[18] + (size_t)e * 512 * 1024; t.WT = ws + WS_WD + (size_t)e * 1024 * 512; t.K = 512; t.drow0 = 32 * nb; t.k0 = 64 * kb; t.n0 = 32 * nb; }
}
constexpr int N_MOE_ITEMS = 32 * 512 + 32 * 256;
#ifndef TAIL_LIGHT
#define TAIL_LIGHT 5600
#endif
#ifndef MOE_ITEMS_A
#define MOE_ITEMS_A 9216
#endif
#ifndef MOE_ITEMS_B
#define MOE_ITEMS_B 16384
#endif
__device__ __forceinline__ void moe_item_load(const TItem& t, f32x4 (&r)[8], int lane) {
    const float* src = t.W + (size_t)(t.k0 + (lane >> 3)) * 1024 + t.n0 + (lane & 7) * 4;
#pragma unroll
    for (int i = 0; i < 8; ++i) r[i] = __builtin_nontemporal_load((const f32x4*)(src + (size_t)i * 8 * 1024));
}
__device__ __forceinline__ void moe_item_store(const TItem& t, const f32x4 (&r)[8], LAS float* scr, int lane) {
#pragma unroll
    for (int i = 0; i < 8; ++i) { LAS float* d = scr + ((lane >> 3) + 8 * i) * 33 + (lane & 7) * 4; d[0] = r[i].x; d[1] = r[i].y; d[2] = r[i].z; d[3] = r[i].w; }
    asm volatile("s_waitcnt lgkmcnt(0)" ::: "memory");
    const int c = lane & 7;
#pragma unroll
    for (int j = 0; j < 4; ++j) { const int n = (lane >> 3) + 8 * j; const LAS float* s = scr + (8 * c) * 33 + n;
        u32x2 o; o.x = pk4_fp8(s[0 * 33] * WSCALE, s[1 * 33] * WSCALE, s[2 * 33] * WSCALE, s[3 * 33] * WSCALE); o.y = pk4_fp8(s[4 * 33] * WSCALE, s[5 * 33] * WSCALE, s[6 * 33] * WSCALE, s[7 * 33] * WSCALE);
        __builtin_nontemporal_store(o, (u32x2*)(t.WT + (size_t)(t.drow0 + n) * t.K + t.k0 + 8 * c)); }
    asm volatile("s_waitcnt lgkmcnt(0)" ::: "memory");
}
__device__ __forceinline__ void ph_moe_convert(const P& p, LAS unsigned char* lds, int first, int last, int wv, int nwv, int wave, int lane) {
    LAS float* scr = (LAS float*)(lds + wave * 16384);
    TItem t[4]; f32x4 r[4][8]; int idx[4];
    const int N_MOE_ITEMS = last;
#pragma unroll
    for (int j = 0; j < 4; ++j) { idx[j] = first + wv + j * nwv; t[j].W = nullptr; t[j].WT = nullptr; t[j].K = 0; t[j].drow0 = 0; t[j].k0 = 0; t[j].n0 = 0; if (idx[j] < N_MOE_ITEMS) { moe_item(p, idx[j], t[j]); moe_item_load(t[j], r[j], lane); } }
    for (;;) {
        if (idx[0] >= N_MOE_ITEMS) break;
#pragma unroll
        for (int j = 0; j < 4; ++j) { if (idx[j] < N_MOE_ITEMS) { moe_item_store(t[j], r[j], scr, lane); idx[j] += 4 * nwv; if (idx[j] < N_MOE_ITEMS) { moe_item(p, idx[j], t[j]); moe_item_load(t[j], r[j], lane); } } }
    }
}
__device__ __forceinline__ void rms_rows4_to_bf16(const float* x, const float* gain, bf16* o, unsigned char* o8, int row0, int lane) {
    f32x4 v[4][4]; float s[4];
#pragma unroll
    for (int q = 0; q < 4; ++q) { const f32x4* xr = (const f32x4*)(x + (size_t)(row0 + q) * DM) + lane;
#pragma unroll
        for (int j = 0; j < 4; ++j) v[q][j] = __builtin_nontemporal_load(xr + 64 * j); }
#pragma unroll
    for (int q = 0; q < 4; ++q) { s[q] = 0.f;
#pragma unroll
        for (int j = 0; j < 4; ++j) s[q] += (v[q][j].x * v[q][j].x + v[q][j].y * v[q][j].y) + (v[q][j].z * v[q][j].z + v[q][j].w * v[q][j].w); }
#pragma unroll
    for (int o_ = 1; o_ < 64; o_ <<= 1) { s[0] += __shfl_xor(s[0], o_); s[1] += __shfl_xor(s[1], o_); s[2] += __shfl_xor(s[2], o_); s[3] += __shfl_xor(s[3], o_); }
    const f32x4* gr = (const f32x4*)gain + lane;
#pragma unroll
    for (int q = 0; q < 4; ++q) { const float rinv = 1.0f / sqrtf(s[q] * (1.f / DM) + EPS); u32x2* ob = (u32x2*)(o + (size_t)(row0 + q) * DM) + lane;
#pragma unroll
        for (int j = 0; j < 4; ++j) { const f32x4 g = gr[64 * j]; const float h0 = v[q][j].x * rinv * g.x, h1 = v[q][j].y * rinv * g.y, h2 = v[q][j].z * rinv * g.z, h3 = v[q][j].w * rinv * g.w; u32x2 w; w.x = cvt_pk_bf16(h0, h1); w.y = cvt_pk_bf16(h2, h3); ob[64 * j] = w;
            if (o8) ((unsigned*)(o8 + (size_t)(row0 + q) * DM))[lane + 64 * j] = pk4_fp8(h0, h1, h2, h3); } }
}
__device__ __forceinline__ void ph_prologue(const P& p, LAS unsigned char* lds, int gw, int NGW, int wave, int lane) {
    LAS float* scr = (LAS float*)(lds + wave * 16384);
    unsigned char* ws = p.ws;
    constexpr int I_IN = 16 * 200, I_PA = 4 * 32, I_PL = 16 * 32, I_OUT = 16 * 32;
    constexpr int NITEMS = I_IN + I_PA + I_PL + I_OUT;
    for (int it = gw; it < NITEMS; it += NGW) {
        int r = it;
        if (r < I_IN) { const int kb = r / 200, nb = r % 200;
            if (32 * nb < QK8_COLS) transpose_item_f8(p.in[3], INW, ws + WS_WG8, 1024, 2048 + 32 * nb, 64 * kb, 32 * nb, scr, lane);
            else if (32 * nb < C_GM) transpose_item(p.in[3], INW, (bf16*)(ws + WS_WIN), 1024, 32 * nb, 64 * kb, 32 * nb, scr, lane);
            else transpose_item_f8(p.in[3], INW, ws + WS_WG8, 1024, 32 * nb - C_GM, 64 * kb, 32 * nb, scr, lane);
            continue; } r -= I_IN;
        if (r < I_PA) { const int kb = r / 32, nb = r % 32; transpose_item(p.in[11], 1024, (bf16*)(ws + WS_WPLA) + 1024, CAW, 32 * nb, 64 * kb, 32 * nb, scr, lane); continue; } r -= I_PA;
        if (r < I_PL) { const int kb = r / 32, nb = r % 32; transpose_item(p.in[12], 1024, (bf16*)(ws + WS_WPLA), CAW, 32 * nb, 64 * kb, 32 * nb, scr, lane); continue; } r -= I_PL;
        { const int kb = r / 32, nb = r % 32; transpose_item(p.in[13], 1024, (bf16*)(ws + WS_WOUT), 1024, 32 * nb, 64 * kb, 32 * nb, scr, lane); }
    }
    for (int m = gw * 4; m < M; m += NGW * 4) rms_rows4_to_bf16(p.in[0], p.in[2], (bf16*)(ws + WS_H), ws + WS_H1F8, m, lane);
    {
        bf16* WRT = (bf16*)(ws + WS_WRT); const float* g2 = p.in[14]; const float* wg = p.in[15]; const float* we = p.in[16];
        for (int e = gw * 64 + lane; e < 48 * 1024; e += NGW * 64) { const int c = e >> 10, k = e & 1023; float v = 0.f;
            if (c < 4) v = wg[k * 4 + c] * g2[k]; else if (c < 36) v = we[k * 32 + (c - 4)] * g2[k];
            const unsigned short hi = f2bf(v); const unsigned short lo = f2bf(v - bf2f(hi)); const int kb = k >> 5, kk = k & 31;
            WRT[((kb * 2 + 0) * 48 + c) * 32 + kk] = hi; WRT[((kb * 2 + 1) * 48 + c) * 32 + kk] = lo; } }
}

typedef short v4i16_t __attribute__((ext_vector_type(4)));
constexpr int AT_KS = 0, AT_KP = 144, AT_VS = 36864, AT_VP = 160, AT_RT = 77824;
constexpr int N_ATT_UNITS = 2 * 3 * 64 * 4;
struct AttStage { u32x4 k[4], v[4]; bf16x8 q[2]; };
__device__ __forceinline__ void att_decode(int U, int& b, int& g, int& h, int& d, int& r, int& nblk) {
    const int hh = U & 3, combo = (U >> 2) & 63, bg = U >> 8; b = bg / 3; g = bg - 3 * b; h = 4 * g + hh; const int dsh = 2 * g; d = 1 << dsh; r = combo >> (6 - dsh); nblk = combo & ((64 >> dsh) - 1);
}
__device__ __forceinline__ int att_v2u(int V) {
    const int bg = V >> 8, rem = V & 255, g = bg - 3 * (bg / 3), nbs = 6 - 2 * g, rh = rem >> nbs, nblk = rem & ((1 << nbs) - 1), r = rh >> 2, head = rh & 3;
    return (bg << 8) | ((((r << nbs) | nblk)) << 2) | head;
}
__device__ __forceinline__ void att_load(AttStage& st, const bf16* __restrict__ PROJ, int U, bool cont, int tid, int w, int fr, int fq) {
    int b, g, h, d, r, nblk; att_decode(U, b, g, h, d, r, nblk);
    const int blk0 = cont ? nblk : nblk - 1;
    { const int key0 = tid >> 3, ch = tid & 7; int kp0 = 128 * blk0 + key0, kp1 = kp0 + 64; kp0 = kp0 < 0 ? 0 : kp0; kp1 = kp1 < 0 ? 0 : kp1;
      const bf16* r0 = PROJ + (size_t)(b * SEQ + kp0 * d + r) * INW + h * 64 + ch * 8; const bf16* r1 = PROJ + (size_t)(b * SEQ + kp1 * d + r) * INW + h * 64 + ch * 8;
      st.k[0] = __builtin_nontemporal_load((const u32x4*)(r0 + C_K)); st.v[0] = __builtin_nontemporal_load((const u32x4*)(r0 + C_V)); st.k[1] = __builtin_nontemporal_load((const u32x4*)(r1 + C_K)); st.v[1] = __builtin_nontemporal_load((const u32x4*)(r1 + C_V));
      if (!cont) { const bf16* r2 = PROJ + (size_t)(b * SEQ + (128 * nblk + key0) * d + r) * INW + h * 64 + ch * 8; const bf16* r3 = PROJ + (size_t)(b * SEQ + (128 * nblk + key0 + 64) * d + r) * INW + h * 64 + ch * 8;
          st.k[2] = __builtin_nontemporal_load((const u32x4*)(r2 + C_K)); st.v[2] = __builtin_nontemporal_load((const u32x4*)(r2 + C_V)); st.k[3] = __builtin_nontemporal_load((const u32x4*)(r3 + C_K)); st.v[3] = __builtin_nontemporal_load((const u32x4*)(r3 + C_V)); } }
    const bf16* qp = PROJ + (size_t)(b * SEQ + (128 * nblk + 16 * w + fr) * d + r) * INW + h * 64 + 8 * fq;
    st.q[0] = __builtin_nontemporal_load((const bf16x8*)qp); st.q[1] = __builtin_nontemporal_load((const bf16x8*)(qp + 32));
}
__device__ __forceinline__ void ph_attention(const bf16* __restrict__ PROJ, const float* __restrict__ rel_bias, bf16* __restrict__ OG, float* __restrict__ LSE, LAS unsigned char* lds, int c, int G, int tid) {
    const int lane = tid & 63, w = __builtin_amdgcn_readfirstlane(tid >> 6), fr = lane & 15, fq = lane >> 4;
    LAS unsigned char* KS = lds + AT_KS; LAS unsigned char* VS = lds + AT_VS; LAS float* RTB = (LAS float*)(lds + AT_RT);
    const int nbase = N_ATT_UNITS / G, nextra = N_ATT_UNITS - nbase * G, vstart = c * nbase + (c < nextra ? c : nextra), vend = vstart + nbase + (c < nextra ? 1 : 0);
    if (vend <= vstart) return;
    lds_barrier();
    for (int e = tid; e < 12 * 160; e += 512) { const int hd = e / 160, x = e - hd * 160, u = x + 112; RTB[e] = (u >= 128 && u <= 256) ? rel_bias[(int)BUCKET[hd >> 2][256 - u] * 12 + hd] : -1e30f; }
    AttStage st; att_load(st, PROJ, att_v2u(vstart), false, tid, w, fr, fq);
    for (int V = vstart; V < vend; ++V) {
        const int U = att_v2u(V);
        int b, g, h, d, r, nblk; att_decode(U, b, g, h, d, r, nblk);
        const bool cont = V > vstart && nblk != 0;
        const int par8 = ((nblk + 1) & 1) * 8;
        __syncthreads();
        { const int key0 = tid >> 3, ch = tid & 7, h0 = ((cont ? nblk : nblk - 1) & 1) << 7, h1 = (nblk & 1) << 7;
          *(LAS u32x4*)(KS + (h0 | key0) * AT_KP + ch * 16) = st.k[0]; *(LAS u32x4*)(VS + (h0 | key0) * AT_VP + ch * 16) = st.v[0];
          *(LAS u32x4*)(KS + (h0 | (key0 + 64)) * AT_KP + ch * 16) = st.k[1]; *(LAS u32x4*)(VS + (h0 | (key0 + 64)) * AT_VP + ch * 16) = st.v[1];
          if (!cont) { *(LAS u32x4*)(KS + (h1 | key0) * AT_KP + ch * 16) = st.k[2]; *(LAS u32x4*)(VS + (h1 | key0) * AT_VP + ch * 16) = st.v[2];
                       *(LAS u32x4*)(KS + (h1 | (key0 + 64)) * AT_KP + ch * 16) = st.k[3]; *(LAS u32x4*)(VS + (h1 | (key0 + 64)) * AT_VP + ch * 16) = st.v[3]; } }
        const bf16x8 q0 = st.q[0], q1 = st.q[1]; const LAS float* RT = RTB + h * 160;
        __syncthreads();
        if (V + 1 < vend) { const int Un = att_v2u(V + 1); att_load(st, PROJ, Un, ((Un >> 2) & ((64 >> (2 * ((Un >> 8) % 3))) - 1)) != 0, tid, w, fr, fq); }
        f32x4 sc[9];
#pragma unroll
        for (int tt = 0; tt < 9; ++tt) { const LAS unsigned char* kp = KS + (16 * ((w + tt + par8) & 15) + fr) * AT_KP + fq * 16;
            f32x4 acc = (f32x4){0.f, 0.f, 0.f, 0.f};
            acc = __builtin_amdgcn_mfma_f32_16x16x32_bf16(*(const LAS bf16x8*)kp, q0, acc, 0, 0, 0);
            acc = __builtin_amdgcn_mfma_f32_16x16x32_bf16(*(const LAS bf16x8*)(kp + 64), q1, acc, 0, 0, 0);
            sc[tt] = acc; }
        float mx = -3.0e38f;
#pragma unroll
        for (int tt = 0; tt < 9; ++tt)
#pragma unroll
            for (int i = 0; i < 4; ++i) { float v = sc[tt][i] + RT[16 * tt + 4 * fq + i - fr + 16];
                if (nblk == 0 && (w + tt) < 8) v = -1e30f;
                sc[tt][i] = v; mx = fmaxf(mx, v); }
        mx = fmaxf(mx, __shfl_xor(mx, 16)); mx = fmaxf(mx, __shfl_xor(mx, 32));
        float ls = 0.f;
#pragma unroll
        for (int tt = 0; tt < 9; ++tt)
#pragma unroll
            for (int i = 0; i < 4; ++i) { const float pv = __builtin_amdgcn_exp2f((sc[tt][i] - mx) * 1.4426950408889634f); sc[tt][i] = pv; ls += pv; }
        f32x4 od[4];
#pragma unroll
        for (int dt = 0; dt < 4; ++dt) od[dt] = (f32x4){0.f, 0.f, 0.f, 0.f};
        const int vq = (lane & 15) >> 2, vp = lane & 3;
#pragma unroll
        for (int kb = 0; kb < 5; ++kb) { const int T0 = w + 2 * kb, T1 = kb < 4 ? T0 + 1 : T0;
            u32x4 pk; pk.x = cvt_pk_bf16(sc[2 * kb][0], sc[2 * kb][1]); pk.y = cvt_pk_bf16(sc[2 * kb][2], sc[2 * kb][3]);
            if (kb < 4) { pk.z = cvt_pk_bf16(sc[2 * kb + 1][0], sc[2 * kb + 1][1]); pk.w = cvt_pk_bf16(sc[2 * kb + 1][2], sc[2 * kb + 1][3]); } else { pk.z = 0u; pk.w = 0u; }
            const bf16x8 pb = __builtin_bit_cast(bf16x8, pk);
            const LAS unsigned char* v0 = VS + (16 * ((T0 + par8) & 15) + 4 * fq + vq) * AT_VP + 8 * vp; const LAS unsigned char* v1 = VS + (16 * ((T1 + par8) & 15) + 4 * fq + vq) * AT_VP + 8 * vp;
#pragma unroll
            for (int dt = 0; dt < 4; ++dt) {
                const v4i16_t a0 = __builtin_amdgcn_ds_read_tr16_b64_v4i16((LAS v4i16_t*)(v0 + dt * 32)), a1 = __builtin_amdgcn_ds_read_tr16_b64_v4i16((LAS v4i16_t*)(v1 + dt * 32));
                bf16x8 va; va[0] = a0[0]; va[1] = a0[1]; va[2] = a0[2]; va[3] = a0[3]; va[4] = a1[0]; va[5] = a1[1]; va[6] = a1[2]; va[7] = a1[3];
                od[dt] = __builtin_amdgcn_mfma_f32_16x16x32_bf16(va, pb, od[dt], 0, 0, 0); } }
        ls += __shfl_xor(ls, 16); ls += __shfl_xor(ls, 32);
        const float inv = 1.0f / ls;
        const size_t orow = (size_t)g * M + (size_t)(b * SEQ + (128 * nblk + 16 * w + fr) * d + r);
        bf16* op = OG + orow * 256 + (h & 3) * 64 + 4 * fq;
#pragma unroll
        for (int dt = 0; dt < 4; ++dt) { u32x2 o; o.x = cvt_pk_bf16(od[dt][0] * inv, od[dt][1] * inv); o.y = cvt_pk_bf16(od[dt][2] * inv, od[dt][3] * inv); *(u32x2*)(op + 16 * dt) = o; }
        if (fq == 0) LSE[(size_t)U * 128 + 16 * w + fr] = mx + __logf(ls);
    }
}

constexpr int LR_WT = 0, LR_XCB = 18432, LR_BF = 36864, LR_AF = 71680, LR_AG = 106496, LR_P = 144, LR_FP = 68;
constexpr int N_LRU_UNITS = 2 * 64 * 16;
struct LruX { u32x4 x[2][4]; };
__device__ __forceinline__ void lru_load_x(LruX& X, const bf16* __restrict__ PROJ, int U, int tid) {
    const int h = U & 15, idx = U >> 4, b = idx >> 6, ck = idx & 63, t0 = ck * 128; const size_t row0 = (size_t)b * SEQ + t0;
#pragma unroll
    for (int it = 0; it < 2; ++it) { const int item = tid + 512 * it, tok = item >> 3, cg = item & 7, c0 = 64 * h + 8 * cg;
#pragma unroll
        for (int j = 0; j < 4; ++j) { const int tt = t0 + tok - 3 + j; u32x4 v = (u32x4){0u, 0u, 0u, 0u};
            if (tt >= 0) v = __builtin_nontemporal_load((const u32x4*)(PROJ + (row0 + tok - 3 + j) * INW + C_XR + c0));
            X.x[it][j] = v; } }
}
__device__ __forceinline__ void ph_lru_local(const bf16* __restrict__ PROJ, const P& p, bf16* __restrict__ HL, bf16* __restrict__ PC, float* __restrict__ AGG, LAS unsigned char* lds, int c, int G, int tid) {
    const float* conv_w = p.in[4]; const float* conv_b = p.in[5]; const float* w_rg = p.in[6]; const float* b_rg = p.in[7]; const float* w_ig = p.in[8]; const float* b_ig = p.in[9]; const float* lam = p.in[10];
    const int lane = tid & 63, w = __builtin_amdgcn_readfirstlane(tid >> 6), fr = lane & 15, fq = lane >> 4;
    LAS unsigned char* WT = lds + LR_WT; LAS unsigned char* XCB = lds + LR_XCB; LAS float* BFl = (LAS float*)(lds + LR_BF); LAS float* AFl = (LAS float*)(lds + LR_AF); LAS float* AG = (LAS float*)(lds + LR_AG);
    int U = c; if (U >= N_LRU_UNITS) return;
    int cur_h = -1;
    float cw[4][8], cb[8], brg[4], big[4], cc[4];
    LruX X; lru_load_x(X, PROJ, U, tid);
    for (; U < N_LRU_UNITS; U += G) {
        const int h = U & 15, idx = U >> 4, b = idx >> 6, ck = idx & 63, t0 = ck * 128; const size_t row0 = (size_t)b * SEQ + t0;
        __syncthreads();
        if (h != cur_h) { cur_h = h;
            for (int e = tid; e < 2 * 64 * 16; e += 512) { const int gate = e >> 10, rem = e & 1023, iin = rem >> 4, j4 = (rem & 15) * 4;
                const f32x4 wv = *(const f32x4*)((gate ? w_ig : w_rg) + (size_t)(h * 64 + iin) * 64 + j4);
                LAS unsigned short* dst = (LAS unsigned short*)(WT + (gate * 64 + j4) * LR_P + iin * 2);
                dst[0] = f2bf(wv.x); dst[LR_P / 2] = f2bf(wv.y); dst[LR_P] = f2bf(wv.z); dst[3 * LR_P / 2] = f2bf(wv.w); }
            { const int c0 = 64 * h + 8 * (tid & 7);
                const f32x4 b0 = *(const f32x4*)(conv_b + c0), b1 = *(const f32x4*)(conv_b + c0 + 4); cb[0] = b0.x; cb[1] = b0.y; cb[2] = b0.z; cb[3] = b0.w; cb[4] = b1.x; cb[5] = b1.y; cb[6] = b1.z; cb[7] = b1.w;
#pragma unroll
                for (int j = 0; j < 4; ++j) { const f32x4 w0 = *(const f32x4*)(conv_w + j * 1024 + c0), w1 = *(const f32x4*)(conv_w + j * 1024 + c0 + 4);
                    cw[j][0] = w0.x; cw[j][1] = w0.y; cw[j][2] = w0.z; cw[j][3] = w0.w; cw[j][4] = w1.x; cw[j][5] = w1.y; cw[j][6] = w1.z; cw[j][7] = w1.w; } }
#pragma unroll
            for (int jt = 0; jt < 4; ++jt) { const int c = 64 * h + 16 * jt + fr; brg[jt] = -1.4426950408889634f * b_rg[c]; big[jt] = -1.4426950408889634f * b_ig[c]; const float nl = -lam[c]; cc[jt] = 8.0f * (nl > 20.f ? nl : log1pf(expf(nl))); } }
#pragma unroll
        for (int it = 0; it < 2; ++it) { const int item = tid + 512 * it, tok = item >> 3, cg = item & 7;
            float xc[8];
#pragma unroll
            for (int q = 0; q < 8; ++q) xc[q] = cb[q];
#pragma unroll
            for (int j = 0; j < 4; ++j) { const u32x4 xv = X.x[it][j];
                xc[0] += cw[j][0] * bflo(xv.x); xc[1] += cw[j][1] * bfhi(xv.x); xc[2] += cw[j][2] * bflo(xv.y); xc[3] += cw[j][3] * bfhi(xv.y);
                xc[4] += cw[j][4] * bflo(xv.z); xc[5] += cw[j][5] * bfhi(xv.z); xc[6] += cw[j][6] * bflo(xv.w); xc[7] += cw[j][7] * bfhi(xv.w); }
            u32x4 pk; pk.x = cvt_pk_bf16(xc[0], xc[1]); pk.y = cvt_pk_bf16(xc[2], xc[3]); pk.z = cvt_pk_bf16(xc[4], xc[5]); pk.w = cvt_pk_bf16(xc[6], xc[7]);
            *(LAS u32x4*)(XCB + tok * LR_P + cg * 16) = pk;
            *(LAS f32x4*)(BFl + tok * LR_FP + cg * 8) = (f32x4){xc[0], xc[1], xc[2], xc[3]}; *(LAS f32x4*)(BFl + tok * LR_FP + cg * 8 + 4) = (f32x4){xc[4], xc[5], xc[6], xc[7]}; }
        __syncthreads();
        if (U + G < N_LRU_UNITS) lru_load_x(X, PROJ, U + G, tid);
        const bf16x8 a0 = *(const LAS bf16x8*)(XCB + (16 * w + fr) * LR_P + fq * 16), a1 = *(const LAS bf16x8*)(XCB + (16 * w + fr) * LR_P + 64 + fq * 16);
#pragma unroll
        for (int jt = 0; jt < 4; ++jt) {
            f32x4 ra = (f32x4){0.f, 0.f, 0.f, 0.f}, ia = (f32x4){0.f, 0.f, 0.f, 0.f};
            const LAS unsigned char* wrp = WT + (16 * jt + fr) * LR_P + fq * 16; const LAS unsigned char* wip = wrp + 64 * LR_P;
            ra = __builtin_amdgcn_mfma_f32_16x16x32_bf16(a0, *(const LAS bf16x8*)wrp, ra, 0, 0, 0); ra = __builtin_amdgcn_mfma_f32_16x16x32_bf16(a1, *(const LAS bf16x8*)(wrp + 64), ra, 0, 0, 0);
            ia = __builtin_amdgcn_mfma_f32_16x16x32_bf16(a0, *(const LAS bf16x8*)wip, ia, 0, 0, 0); ia = __builtin_amdgcn_mfma_f32_16x16x32_bf16(a1, *(const LAS bf16x8*)(wip + 64), ia, 0, 0, 0);
            const int ch = 16 * jt + fr;
#pragma unroll
            for (int i = 0; i < 4; ++i) { const int tok = 16 * w + 4 * fq + i;
                const float rg = __builtin_amdgcn_rcpf(1.0f + __builtin_amdgcn_exp2f(__builtin_fmaf(ra[i], -1.4426950408889634f, brg[jt])));
                const float ig = __builtin_amdgcn_rcpf(1.0f + __builtin_amdgcn_exp2f(__builtin_fmaf(ia[i], -1.4426950408889634f, big[jt])));
                const float x = -cc[jt] * rg, av = __builtin_amdgcn_exp2f(x * 1.4426950408889634f), x2 = x + x;
                const float om = x2 > -0.02f ? -x2 * (1.0f + x2 * (0.5f + x2 * (1.0f / 6.0f))) : 1.0f - av * av;
                const float xcv = BFl[tok * LR_FP + ch];
                AFl[tok * LR_FP + ch] = av; BFl[tok * LR_FP + ch] = __builtin_amdgcn_sqrtf(om) * (ig * xcv); } }
        __syncthreads();
        float Ps[16], hs[16]; { float Pr = 1.f, hr = 0.f;
#pragma unroll
            for (int t = 0; t < 16; ++t) { const float av = AFl[(16 * w + t) * LR_FP + lane], bv = BFl[(16 * w + t) * LR_FP + lane]; Pr *= av; hr = av * hr + bv; Ps[t] = Pr; hs[t] = hr; }
            AG[w * 128 + lane] = Pr; AG[w * 128 + 64 + lane] = hr; }
        __syncthreads();
        float Ain = 1.f, Hin = 0.f;
        for (int k = 0; k < w; ++k) { const float ak = AG[k * 128 + lane], hk = AG[k * 128 + 64 + lane]; Hin = ak * Hin + hk; Ain *= ak; }
        bf16* hlp = HL + (row0 + 16 * w) * DM + 64 * h + lane; unsigned char* pcp = (unsigned char*)PC + (row0 + 16 * w) * DM + 64 * h + lane;
#pragma unroll
        for (int t = 0; t < 16; ++t) { hlp[(size_t)t * DM] = f2bf(hs[t] + Ps[t] * Hin); pcp[(size_t)t * DM] = (unsigned char)__builtin_amdgcn_cvt_pk_u8_f32(__builtin_rintf(Ps[t] * Ain * 255.f), 0, 0u); }
        if (w == 7) { float* ag = AGG + ((size_t)(b * 64 + ck) * 2) * 1024 + 64 * h + lane; ag[0] = Ps[15] * Ain; ag[1024] = hs[15] + Ps[15] * Hin; }
    }
}

__device__ __forceinline__ void ph_fixup(const bf16* __restrict__ HL, const bf16* __restrict__ PC, const float* __restrict__ AGG, const bf16* __restrict__ PROJ, bf16* __restrict__ LRUO,
                                         const bf16* __restrict__ OG, const float* __restrict__ LSE, bf16* __restrict__ ATT, int G, int tid, int do_merge) {
    for (int U0 = (int)blockIdx.x; U0 < 256; U0 += G) { const int U = G == 256 ? team_rows64(U0) : U0;
        const int half = U & 1, idx = U >> 1, b = idx >> 6, ck = idx & 63, c0 = 8 * (tid & 127), rg = tid >> 7;
        const size_t row0 = (size_t)b * SEQ + ck * 128 + half * 64 + rg * 16;
        u32x4 hl8[8], gg8[8]; u32x2 pc8[8];
#pragma unroll
        for (int i = 0; i < 8; ++i) { const size_t r = row0 + i; hl8[i] = __builtin_nontemporal_load((const u32x4*)(HL + r * DM + c0)); gg8[i] = __builtin_nontemporal_load((const u32x4*)(PROJ + r * INW + C_GL + c0)); pc8[i] = __builtin_nontemporal_load((const u32x2*)((const unsigned char*)PC + r * DM + c0)); }
        float cr[8];
#pragma unroll
        for (int q = 0; q < 8; ++q) cr[q] = 0.f;
#pragma unroll 8
        for (int k = 0; k < ck; ++k) { const float* ap = AGG + ((size_t)(b * 64 + k) * 2) * 1024 + c0; const f32x4 a0 = *(const f32x4*)ap, a1 = *(const f32x4*)(ap + 4), b0 = *(const f32x4*)(ap + 1024), b1 = *(const f32x4*)(ap + 1028);
            cr[0] = a0.x * cr[0] + b0.x; cr[1] = a0.y * cr[1] + b0.y; cr[2] = a0.z * cr[2] + b0.z; cr[3] = a0.w * cr[3] + b0.w; cr[4] = a1.x * cr[4] + b1.x; cr[5] = a1.y * cr[5] + b1.y; cr[6] = a1.z * cr[6] + b1.z; cr[7] = a1.w * cr[7] + b1.w; }
        constexpr float S = 1.0f / 255.0f;
#define FIX_ROW(r, hl, pc, gg) do { u32x4 o; \
            o.x = cvt_pk_bf16((bflo(hl.x) + ub0(pc.x) * S * cr[0]) * gelu_tanh_f(bflo(gg.x)), (bfhi(hl.x) + ub1(pc.x) * S * cr[1]) * gelu_tanh_f(bfhi(gg.x))); \
            o.y = cvt_pk_bf16((bflo(hl.y) + ub2(pc.x) * S * cr[2]) * gelu_tanh_f(bflo(gg.y)), (bfhi(hl.y) + ub3(pc.x) * S * cr[3]) * gelu_tanh_f(bfhi(gg.y))); \
            o.z = cvt_pk_bf16((bflo(hl.z) + ub0(pc.y) * S * cr[4]) * gelu_tanh_f(bflo(gg.z)), (bfhi(hl.z) + ub1(pc.y) * S * cr[5]) * gelu_tanh_f(bfhi(gg.z))); \
            o.w = cvt_pk_bf16((bflo(hl.w) + ub2(pc.y) * S * cr[6]) * gelu_tanh_f(bflo(gg.w)), (bfhi(hl.w) + ub3(pc.y) * S * cr[7]) * gelu_tanh_f(bfhi(gg.w))); \
            st_wt16(LRUO + (r) * CAW + c0, o); } while (0)
        u32x4 hlb[8], ggb[8]; u32x2 pcb[8];
#pragma unroll
        for (int i = 0; i < 8; ++i) { const size_t r = row0 + 8 + i; hlb[i] = __builtin_nontemporal_load((const u32x4*)(HL + r * DM + c0)); ggb[i] = __builtin_nontemporal_load((const u32x4*)(PROJ + r * INW + C_GL + c0)); pcb[i] = __builtin_nontemporal_load((const u32x2*)((const unsigned char*)PC + r * DM + c0)); }
#pragma unroll
        for (int i = 0; i < 8; ++i) FIX_ROW(row0 + i, hl8[i], pc8[i], gg8[i]);
#pragma unroll
        for (int i = 0; i < 8; ++i) FIX_ROW(row0 + 8 + i, hlb[i], pcb[i], ggb[i]);
#undef FIX_ROW
    }
    if (do_merge) for (int it0 = (int)blockIdx.x * 512 + tid; it0 < M * 32; it0 += G * 512) { const int it = G == 256 ? (team_rows64((int)blockIdx.x) * 2048 + (it0 - (int)blockIdx.x * 512) / (G * 512) * 512 + tid) : it0;
        const int row = it >> 5, cg = it & 31, hh = cg >> 3;
        const int bb = row >> 13, tt = row & (SEQ - 1);
        float lv[3];
#pragma unroll
        for (int g = 0; g < 3; ++g) { const int dsh = 2 * g, r = tt & ((1 << dsh) - 1), m = tt >> dsh, nblk = m >> 7, qi = m & 127, combo = r * (64 >> dsh) + nblk;
            lv[g] = LSE[(size_t)((((bb * 3 + g) << 8) | (combo << 2) | hh)) * 128 + qi]; }
        const float l0 = lv[0], l1 = lv[1], l2 = lv[2];
        const float ml = fmaxf(fmaxf(l0, l1), l2); float w0 = __expf(l0 - ml), w1 = __expf(l1 - ml), w2 = __expf(l2 - ml); const float wi = 1.0f / (w0 + w1 + w2); w0 *= wi; w1 *= wi; w2 *= wi;
        const u32x4 o0 = __builtin_nontemporal_load((const u32x4*)(OG + (size_t)row * 256 + cg * 8)), o1 = __builtin_nontemporal_load((const u32x4*)(OG + ((size_t)M + row) * 256 + cg * 8)), o2 = __builtin_nontemporal_load((const u32x4*)(OG + ((size_t)2 * M + row) * 256 + cg * 8));
        u32x4 o;
        o.x = cvt_pk_bf16(w0 * bflo(o0.x) + w1 * bflo(o1.x) + w2 * bflo(o2.x), w0 * bfhi(o0.x) + w1 * bfhi(o1.x) + w2 * bfhi(o2.x));
        o.y = cvt_pk_bf16(w0 * bflo(o0.y) + w1 * bflo(o1.y) + w2 * bflo(o2.y), w0 * bfhi(o0.y) + w1 * bfhi(o1.y) + w2 * bfhi(o2.y));
        o.z = cvt_pk_bf16(w0 * bflo(o0.z) + w1 * bflo(o1.z) + w2 * bflo(o2.z), w0 * bfhi(o0.z) + w1 * bfhi(o1.z) + w2 * bfhi(o2.z));
        o.w = cvt_pk_bf16(w0 * bflo(o0.w) + w1 * bflo(o1.w) + w2 * bflo(o2.w), w0 * bfhi(o0.w) + w1 * bfhi(o1.w) + w2 * bfhi(o2.w));
        st_wt16(ATT + (size_t)row * CAW + cg * 8, o);
    }
}

constexpr int RT_LG = 0, RT_SS = RT_LG + 2 * 64 * 48 * 4, RT_CNT = RT_SS + 2 * 64 * 4, RT_BASE = RT_CNT + 32 * 4;
__device__ __forceinline__ void ph_router(const float* __restrict__ X1, const bf16* __restrict__ DELTA, bf16* __restrict__ X1B, const P& p, unsigned char* __restrict__ H2, int* __restrict__ ROUTE, int* __restrict__ TOK, unsigned* __restrict__ cnt, LAS unsigned char* lds, int G, int tid) {
    const float* g2 = p.in[14]; const bf16* WRT = (const bf16*)(p.ws + WS_WRT);
    const int lane = tid & 63, w = __builtin_amdgcn_readfirstlane(tid >> 6), fr = lane & 15, fq = lane >> 4, rt = w & 3, kh = w >> 2;
    LAS float* LG = (LAS float*)(lds + RT_LG); LAS float* SS = (LAS float*)(lds + RT_SS); LAS unsigned* LC = (LAS unsigned*)(lds + RT_CNT); LAS unsigned* LB = (LAS unsigned*)(lds + RT_BASE);
    for (int rb0 = (int)blockIdx.x; rb0 < M / 64; rb0 += G) { const int rb = G == 256 ? team_rows64(rb0) : rb0;
        const int row = rb * 64 + 16 * rt + fr; const float* xp = X1 + (size_t)row * DM + kh * 512 + 8 * fq;
        f32x4 xs[16][2];
#pragma unroll
        for (int ks = 0; ks < 16; ++ks) { xs[ks][0] = __builtin_nontemporal_load((const f32x4*)(xp + 32 * ks)); xs[ks][1] = __builtin_nontemporal_load((const f32x4*)(xp + 32 * ks + 4)); }
        { const unsigned char* dp = (const unsigned char*)DELTA + (size_t)((rb * 8 + w) * 16) * 1024 + lane * 16;
#pragma unroll
            for (int ks = 0; ks < 16; ++ks) { const u32x4 d = __builtin_nontemporal_load((const u32x4*)(dp + 1024 * ks));
                xs[ks][0].x += bflo(d.x); xs[ks][0].y += bfhi(d.x); xs[ks][0].z += bflo(d.y); xs[ks][0].w += bfhi(d.y); xs[ks][1].x += bflo(d.z); xs[ks][1].y += bfhi(d.z); xs[ks][1].z += bflo(d.w); xs[ks][1].w += bfhi(d.w); } }
        if (tid < 32) LC[tid] = 0u;
        f32x4 acc[3]; acc[0] = (f32x4){0.f, 0.f, 0.f, 0.f}; acc[1] = acc[0]; acc[2] = acc[0]; float ss = 0.f;
        const bf16* wq = WRT + ((kh * 16) * 96 + fr) * 32 + 8 * fq;
        bf16* xb = X1B + (size_t)row * DM + kh * 512 + 8 * fq;
        bf16x8 bh[2][3], bl[2][3];
#pragma unroll
        for (int ct = 0; ct < 3; ++ct) { bh[0][ct] = *(const bf16x8*)(wq + ct * 16 * 32); bl[0][ct] = *(const bf16x8*)(wq + (48 + ct * 16) * 32); }
#pragma unroll
        for (int ks = 0; ks < 16; ++ks) {
            wq += 96 * 32; asm volatile("" : "+v"(wq) :: "memory");
            if (ks < 15) {
#pragma unroll
                for (int ct = 0; ct < 3; ++ct) { bh[(ks + 1) & 1][ct] = *(const bf16x8*)(wq + ct * 16 * 32); bl[(ks + 1) & 1][ct] = *(const bf16x8*)(wq + (48 + ct * 16) * 32); } }
            const f32x4 x0 = xs[ks][0], x1 = xs[ks][1];
            ss += (x0.x * x0.x + x0.y * x0.y) + (x0.z * x0.z + x0.w * x0.w) + (x1.x * x1.x + x1.y * x1.y) + (x1.z * x1.z + x1.w * x1.w);
            u32x4 hi, lo;
            hi.x = cvt_pk_bf16(x0.x, x0.y); hi.y = cvt_pk_bf16(x0.z, x0.w); hi.z = cvt_pk_bf16(x1.x, x1.y); hi.w = cvt_pk_bf16(x1.z, x1.w);
            lo.x = cvt_pk_bf16(x0.x - bflo(hi.x), x0.y - bfhi(hi.x)); lo.y = cvt_pk_bf16(x0.z - bflo(hi.y), x0.w - bfhi(hi.y));
            lo.z = cvt_pk_bf16(x1.x - bflo(hi.z), x1.y - bfhi(hi.z)); lo.w = cvt_pk_bf16(x1.z - bflo(hi.w), x1.w - bfhi(hi.w));
            *(u32x4*)(xb + 32 * ks) = hi;
            const bf16x8 ah = __builtin_bit_cast(bf16x8, hi), al = __builtin_bit_cast(bf16x8, lo);
#pragma unroll
            for (int ct = 0; ct < 3; ++ct) {
                acc[ct] = __builtin_amdgcn_mfma_f32_16x16x32_bf16(ah, bh[ks & 1][ct], acc[ct], 0, 0, 0);
                acc[ct] = __builtin_amdgcn_mfma_f32_16x16x32_bf16(ah, bl[ks & 1][ct], acc[ct], 0, 0, 0);
                acc[ct] = __builtin_amdgcn_mfma_f32_16x16x32_bf16(al, bh[ks & 1][ct], acc[ct], 0, 0, 0); } }
        ss += __shfl_xor(ss, 16); ss += __shfl_xor(ss, 32);
#pragma unroll
        for (int ct = 0; ct < 3; ++ct)
#pragma unroll
            for (int i = 0; i < 4; ++i) LG[(kh * 64 + 16 * rt + 4 * fq + i) * 48 + 16 * ct + fr] = acc[ct][i];
        if (fq == 0) SS[kh * 64 + 16 * rt + fr] = ss;
        __syncthreads();
        const float rinv = 1.0f / sqrtf((SS[16 * rt + fr] + SS[64 + 16 * rt + fr]) * (1.f / DM) + EPS);
        unsigned char* hp = H2 + (size_t)row * DM + kh * 512 + 8 * fq; const float* gp = g2 + kh * 512 + 8 * fq;
#pragma unroll
        for (int ks = 0; ks < 16; ++ks) { const f32x4 ga = *(const f32x4*)(gp + 32 * ks), gb = *(const f32x4*)(gp + 32 * ks + 4); const f32x4 x0 = xs[ks][0], x1 = xs[ks][1];
            u32x2 o; o.x = pk4_fp8(x0.x * rinv * ga.x, x0.y * rinv * ga.y, x0.z * rinv * ga.z, x0.w * rinv * ga.w); o.y = pk4_fp8(x1.x * rinv * gb.x, x1.y * rinv * gb.y, x1.z * rinv * gb.z, x1.w * rinv * gb.w);
            *(u32x2*)(hp + 32 * ks) = o; asm volatile("" ::: "memory"); }
        if (w == 0) {
            const int r = rb * 64 + lane; const float ri = 1.0f / sqrtf((SS[lane] + SS[64 + lane]) * (1.f / DM) + EPS);
            const LAS float* l0 = LG + lane * 48; const LAS float* l1 = LG + (64 + lane) * 48;
            float lgt[4];
#pragma unroll
            for (int c = 0; c < 4; ++c) lgt[c] = (l0[c] + l1[c]) * ri;
            int gs = 0; float gm = lgt[0];
#pragma unroll
            for (int c = 1; c < 4; ++c) if (lgt[c] > gm) { gm = lgt[c]; gs = c; }
            float den = 0.f;
#pragma unroll
            for (int c = 0; c < 4; ++c) den += expf(lgt[c] - gm);
            const float psel = 1.0f / den;
            float ls[8];
#pragma unroll
            for (int c = 0; c < 8; ++c) ls[c] = (l0[4 + gs * 8 + c] + l1[4 + gs * 8 + c]) * ri;
            int i1 = 0; float v1 = ls[0];
#pragma unroll
            for (int c = 1; c < 8; ++c) if (ls[c] > v1) { v1 = ls[c]; i1 = c; }
            int i2 = -1; float v2 = -3.0e38f;
#pragma unroll
            for (int c = 0; c < 8; ++c) if (c != i1 && ls[c] > v2) { v2 = ls[c]; i2 = c; }
            const float e2 = expf(v2 - v1); const float w1 = psel / (1.f + e2), w2 = psel * e2 / (1.f + e2);
            const int ea = gs * 8 + i1, eb = gs * 8 + i2;
            const unsigned la = __hip_atomic_fetch_add(LC + ea, 1u, __ATOMIC_RELAXED, __HIP_MEMORY_SCOPE_WORKGROUP);
            const unsigned lb = __hip_atomic_fetch_add(LC + eb, 1u, __ATOMIC_RELAXED, __HIP_MEMORY_SCOPE_WORKGROUP);
            asm volatile("s_waitcnt lgkmcnt(0)" ::: "memory");
            if (lane < 32) { const unsigned n = LC[lane]; LB[lane] = n ? atomicAdd(cnt + lane, n) : 0u; }
            asm volatile("s_waitcnt vmcnt(0) lgkmcnt(0)" ::: "memory");
            const int sa = (int)(LB[ea] + la), sb = (int)(LB[eb] + lb);
            __hip_atomic_store(TOK + ea * CAP + sa, r, __ATOMIC_RELAXED, __HIP_MEMORY_SCOPE_AGENT); __hip_atomic_store(TOK + eb * CAP + sb, r, __ATOMIC_RELAXED, __HIP_MEMORY_SCOPE_AGENT);
            int* rr = ROUTE + (size_t)r * 8; rr[0] = ea; rr[1] = eb; rr[2] = sa; rr[3] = sb; ((float*)rr)[4] = w1; ((float*)rr)[5] = w2;
        }
        __syncthreads();
    }
}

__device__ __forceinline__ void ph_final(const bf16* __restrict__ X1B, float* __restrict__ OUT, const unsigned char* __restrict__ Y, const int* __restrict__ ROUTE, const unsigned* __restrict__ cnt, const float* __restrict__ gf, int gw, int NGW, int lane) {
    int tiles = lane < NEXP ? (int)((cnt[lane] + 255u) >> 8) : 0; int incl = tiles;
#pragma unroll
    for (int o = 1; o < 32; o <<= 1) { const int n = __shfl_up(incl, o); if (lane >= o) incl += n; }
    const int cbase = (incl - tiles) * 256;
    f32x4 g[4];
#pragma unroll
    for (int j = 0; j < 4; ++j) g[j] = *((const f32x4*)gf + lane + 64 * j);
    for (int row0 = gw * 4; row0 < M; row0 += NGW * 4) {
        int ea = 0, eb = 0, sa = 0, sb = 0; float w1 = 0.f, w2 = 0.f;
        if (lane < 4) { const int* r = ROUTE + (size_t)(row0 + lane) * 8; const u32x4 a = *(const u32x4*)r; const f32x2 b = *(const f32x2*)(r + 4); ea = (int)a.x; eb = (int)a.y; sa = (int)a.z; sb = (int)a.w; w1 = b.x; w2 = b.y; }
        const int pa = __shfl(cbase, ea) + sa, pb = __shfl(cbase, eb) + sb;
        f32x4 v[4][4]; unsigned ya[4][4], yb[4][4]; u32x2 dl[4][4]; float wa[4], wb[4];
#pragma unroll
        for (int q = 0; q < 4; ++q) { const int qa = __shfl(pa, q), qb = __shfl(pb, q); wa[q] = __shfl(w1, q) * YINV; wb[q] = __shfl(w2, q) * YINV;
            const unsigned* pya = (const unsigned*)(Y + (size_t)qa * DM) + lane; const unsigned* pyb = (const unsigned*)(Y + (size_t)qb * DM) + lane;
#pragma unroll
            for (int j = 0; j < 4; ++j) { ya[q][j] = __builtin_nontemporal_load(pya + 64 * j); yb[q][j] = __builtin_nontemporal_load(pyb + 64 * j); dl[q][j] = __builtin_nontemporal_load((const u32x2*)(X1B + (size_t)(row0 + q) * DM) + lane + 64 * j); } }
        float s[4];
#pragma unroll
        for (int q = 0; q < 4; ++q) { s[q] = 0.f;
#pragma unroll
            for (int j = 0; j < 4; ++j) { const u32x2 d = dl[q][j]; f32x4 t; t.x = bflo(d.x); t.y = bfhi(d.x); t.z = bflo(d.y); t.w = bfhi(d.y);
                const f32x2 a0 = __builtin_amdgcn_cvt_pk_f32_fp8((int)ya[q][j], false), a1 = __builtin_amdgcn_cvt_pk_f32_fp8((int)ya[q][j], true), b0 = __builtin_amdgcn_cvt_pk_f32_fp8((int)yb[q][j], false), b1 = __builtin_amdgcn_cvt_pk_f32_fp8((int)yb[q][j], true);
                t.x += wa[q] * a0.x + wb[q] * b0.x; t.y += wa[q] * a0.y + wb[q] * b0.y; t.z += wa[q] * a1.x + wb[q] * b1.x; t.w += wa[q] * a1.y + wb[q] * b1.y;
                v[q][j] = t; s[q] += (t.x * t.x + t.y * t.y) + (t.z * t.z + t.w * t.w); }
            asm volatile("" : "+v"(s[q]) :: "memory"); }
#pragma unroll
        for (int o = 1; o < 64; o <<= 1) { s[0] += __shfl_xor(s[0], o); s[1] += __shfl_xor(s[1], o); s[2] += __shfl_xor(s[2], o); s[3] += __shfl_xor(s[3], o); }
#pragma unroll
        for (int q = 0; q < 4; ++q) { const float rinv = 1.0f / sqrtf(s[q] * (1.f / DM) + EPS); f32x4* xr = (f32x4*)(OUT + (size_t)(row0 + q) * DM) + lane;
#pragma unroll
            for (int j = 0; j < 4; ++j) { f32x4 o; o.x = v[q][j].x * rinv * g[j].x; o.y = v[q][j].y * rinv * g[j].y; o.z = v[q][j].z * rinv * g[j].z; o.w = v[q][j].w * rinv * g[j].w; __builtin_nontemporal_store(o, xr + 64 * j); } }
    }
}

constexpr int NPHASE = 9;
__global__ void __launch_bounds__(512, 2) mega_fwd(P p) {
    extern __shared__ __attribute__((aligned(16))) unsigned char lds_raw[];
    LAS unsigned char* lds = (LAS unsigned char*)lds_raw;
    const int G = (int)gridDim.x;
#define IDS() const int tid = fresh_tid(), lane = tid & 63, wave = __builtin_amdgcn_readfirstlane(tid >> 6), gw = (int)blockIdx.x * NWAVES + wave, NGW = G * NWAVES, gt = (int)blockIdx.x * 512 + tid, NGT = G * 512; (void)lane; (void)gw; (void)NGW; (void)gt; (void)NGT
    unsigned char* ws = p.ws;
    gu32* ctl = (gu32*)(ws + WS_CTL);
    { IDS(); for (int u = tid; u < (LDS_BYTES - 131072) / 4; u += 512) ((LAS unsigned*)(lds + 131072))[u] = 0u; }
    __syncthreads();
    volatile LAS unsigned* MISC = (volatile LAS unsigned*)(lds + MISC_OFF);
    XcdBarrier bar = xcd_barrier_post((unsigned*)ctl + CW_BAR, MISC + 8);
    const int lo = p.ph_lo, hi = p.ph_hi;
#define IN(k) (lo <= (k) && (k) < hi)
    bf16* PROJ = (bf16*)(ws + WS_PROJ); bf16* H = (bf16*)(ws + WS_H); unsigned* cnt = (unsigned*)(ws + WS_CTL) + CW_CNT;
    LAS int* tab = (LAS int*)(lds + TAB_OFF);

#define RUN(k, BODY) do { if (IN(k)) { BODY; if (REPEAT_PHASE == (k)) { xcd_barrier(bar); BODY; } } if (IN(k) && IN((k) + 1)) { if (G == 256 && (k) >= 3 && (k) <= 5) team_barrier((unsigned*)ctl, 4u * ((k) - 2)); else xcd_barrier(bar); } } while (0)
#define PHASE_0 { IDS(); ph_prologue(p, lds, gw, NGW, wave, lane); }
#define PHASE_1 { const int NG = G >= 256 ? 229 : G; const int NA = G >= 256 ? MOE_ITEMS_A : 0; const int NB = G >= 256 ? MOE_ITEMS_B : 0;     \
        if ((int)blockIdx.x < NG) { \
            { pg8::Gemm g{H, (const bf16*)(ws + WS_WIN) + (size_t)QK8_COLS * 1024, M, C_GM - QK8_COLS, 1024, 0}; EpiProj E{PROJ, ws + WS_G8, QK8_COLS / 256}; pg8::StaticOrder S; S.init(M, C_GM - QK8_COLS, 2048, NG, (int)blockIdx.x);       \
              pg8::gemm_phase<EpiProj, pg8::StaticOrder, false, true, true>(lds, g, S, E); } \
            { pg8::Gemm g{(const bf16*)(ws + WS_H1F8), (const bf16*)(ws + WS_WG8), M, 2048 + QK8_COLS, 1024, 0}; EpiGate8 E{ws + WS_G8, PROJ}; pg8::StaticOrder S; S.init(M, 2048 + QK8_COLS, 1024, NG, ((int)blockIdx.x + NG - (((M / 256) * ((C_GM - QK8_COLS) / 256)) % NG)) % NG);     \
              pg8::gemm_phase<EpiGate8, pg8::StaticOrder, true, true, true>(lds, g, S, E); } } \
        else { IDS(); ph_moe_convert(p, lds, 0, NA, ((int)blockIdx.x - NG) * NWAVES + wave, (G - NG) * NWAVES, wave, lane); } \
        { IDS(); const int NL0 = ((M / 256) * ((C_GM - QK8_COLS) / 256)) % NG, NX = G >= 256 ? TAIL_LIGHT : 0;     \
          if (NX > 0 && (int)blockIdx.x >= NL0 && (int)blockIdx.x < NG) ph_moe_convert(p, lds, NB, NB + NX, ((int)blockIdx.x - NL0) * NWAVES + wave, (NG - NL0) * NWAVES, wave, lane); \
          ph_moe_convert(p, lds, NB + NX, N_MOE_ITEMS, gw, NGW, wave, lane); } }
#define PHASE_2 { const int NC = G >= 256 ? 224 : G;       \
        if ((int)blockIdx.x < NC) { ph_attention(PROJ, p.in[1], (bf16*)(ws + WS_OG), (float*)(ws + WS_LSE), lds, ((int)blockIdx.x + (NC - 32)) % NC, NC, fresh_tid());     \
            ph_lru_local(PROJ, p, (bf16*)(ws + WS_HL), (bf16*)(ws + WS_PC), (float*)(ws + WS_AGG), lds, (int)blockIdx.x, NC, fresh_tid()); } \
        else { IDS(); ph_moe_convert(p, lds, MOE_ITEMS_A, MOE_ITEMS_B, ((int)blockIdx.x - NC) * NWAVES + wave, (G - NC) * NWAVES, wave, lane); } }
#define PHASE_3 { ph_fixup((const bf16*)(ws + WS_HL), (const bf16*)(ws + WS_PC), (const float*)(ws + WS_AGG), PROJ, (bf16*)(ws + WS_CA), (const bf16*)(ws + WS_OG), (const float*)(ws + WS_LSE), (bf16*)(ws + WS_CA) + 1024, G, fresh_tid(), 1); }
#define PHASE_4 { pg8::Gemm g{(const bf16*)(ws + WS_CA), (const bf16*)(ws + WS_WPLA), M, 1024, CAW, 0}; EpiGateMid E{(bf16*)(ws + WS_MERGED), ws + WS_G8, true}; pg8::StaticOrder S; S.init(M, 1024, CAW * 2, G, (int)blockIdx.x); \
        pg8::gemm_phase<EpiGateMid, pg8::StaticOrder, false, false, true>(lds, g, S, E); }
#define PHASE_5 { pg8::Gemm g{(const bf16*)(ws + WS_MERGED), (const bf16*)(ws + WS_WOUT), M, 1024, 1024, 0}; EpiPlain E{ws + WS_DELTA, 1024, 1.0f}; pg8::StaticOrder S; S.init(M, 1024, 2048, G, (int)blockIdx.x); \
        pg8::gemm_phase<EpiPlain, pg8::StaticOrder, false, false, true>(lds, g, S, E); }
#define PHASE_6 { ph_router(p.in[0], (const bf16*)(ws + WS_DELTA), (bf16*)(ws + WS_X1B), p, (unsigned char*)H, (int*)(ws + WS_ROUTE), (int*)(ws + WS_TOK), cnt, lds, G, fresh_tid()); }
#define PHASE_7 { build_moe_table(tab, cnt, fresh_tid()); __syncthreads(); \
        { pg8::Gemm g{H, (const bf16*)(ws + WS_WGU), MAXTILES * 256, 1024, 1024, 0}; EpiSwiglu E{ws + WS_ACT}; \
          MoeOrderT<0> S; S.tab = tab; S.tok = (const int*)(ws + WS_TOK); S.cnt = cnt; S.ctl = (unsigned*)ctl; S.G = G; S.c = (int)blockIdx.x; S.rb = 1024; S.gather = 1; S.bstride = (size_t)1024 * 1024; \
          pg8::gemm_phase<EpiSwiglu, MoeOrderT<0>, true, true, true>(lds, g, S, E); } \
        { pg8::Gemm g{(const bf16*)(ws + WS_ACT), (const bf16*)(ws + WS_WD), MAXTILES * 256, 1024, 512, 0}; EpiY8 E{ws + WS_Y, WINV * YSCALE}; \
          MoeOrderT<1> S; S.tab = tab; S.tok = (const int*)(ws + WS_TOK); S.cnt = cnt; S.ctl = (unsigned*)ctl; S.G = G; S.c = (int)blockIdx.x; S.rb = 512; S.gather = 0; S.bstride = (size_t)1024 * 512; \
          pg8::gemm_phase<EpiY8, MoeOrderT<1>, true, true, true>(lds, g, S, E); } }
#define PHASE_8 { IDS(); ph_final((const bf16*)(ws + WS_X1B), p.out, ws + WS_Y, (const int*)(ws + WS_ROUTE), cnt, p.in[19], gw, NGW, lane); }
    RUN(0, PHASE_0); RUN(1, PHASE_1);
    RUN(2, PHASE_2); RUN(3, PHASE_3); RUN(4, PHASE_4); RUN(5, PHASE_5); RUN(6, PHASE_6); RUN(7, PHASE_7); RUN(8, PHASE_8);
#undef IN
#undef IDS
}

#ifndef MK_PER_PHASE
#define MK_PER_PHASE 0
#endif
extern "C" void kernel_launch(void* const* d_in, const int* in_sizes, int n_in, void* d_out, int out_size, void* d_ws, size_t ws_size, hipStream_t stream) {
    static int grid = 0;
    if (grid == 0) {
        if (n_in != 20 || out_size != M * DM || ws_size < WS_END) { fprintf(stderr, "kernel_launch: unexpected shapes (n_in %d out %d ws %zu)\n", n_in, out_size, ws_size); grid = -1; return; }
        int dev = 0, cus = 0, per_cu = 0; if (hipGetDevice(&dev) != hipSuccess || hipDeviceGetAttribute(&cus, hipDeviceAttributeMultiprocessorCount, dev) != hipSuccess) { grid = -1; return; }
        if (hipFuncSetAttribute((const void*)mega_fwd, hipFuncAttributeMaxDynamicSharedMemorySize, LDS_BYTES) != hipSuccess) { grid = -1; return; }
        if (hipOccupancyMaxActiveBlocksPerMultiprocessor(&per_cu, (const void*)mega_fwd, 512, LDS_BYTES) != hipSuccess || per_cu < 1) { fprintf(stderr, "kernel_launch: occupancy query says %d\n", per_cu); (void)hipGetLastError(); grid = -1; return; }
        grid = cus;
    }
    if (grid < 0) return;
    unsigned char* ws = (unsigned char*)d_ws;
    (void)hipMemsetAsync(ws + WS_CTL, 0, CTL_ZERO_BYTES, stream);
    P p{}; for (int i = 0; i < 20; ++i) p.in[i] = (const float*)d_in[i]; p.out = (float*)d_out; p.ws = ws;
#if MK_PER_PHASE
    for (int k = 0; k < NPHASE; ++k) { p.ph_lo = k; p.ph_hi = k + 1; hipLaunchKernelGGL(mega_fwd, dim3(grid), dim3(512), LDS_BYTES, stream, p); }
#else
    p.ph_lo = 0; p.ph_hi = NPHASE; hipLaunchKernelGGL(mega_fwd, dim3(grid), dim3(512), LDS_BYTES, stream, p);
#endif
}
```
